# Optimizing an MI355X kernel written in HIP

```python
import math
import jax, jax.numpy as jnp
from jax import lax
import numpy as np

D_MODEL = 1024
BATCH = 16
SEQ = 4096
DEPTH = 2

N_MIXERS = 2
DA_HEADS = 8
DA_HEAD_DIM = 64
DA_VDIM = 2 * DA_HEAD_DIM
Q_BLOCK = 128
REL_BUCKETS = 32
REL_MAX_DIST = 128
SG_CHUNK = 128
SG_GROUPS = 8
SG_HALF = 3 * D_MODEL
SG_GROUP_DIM = SG_HALF // SG_GROUPS
MOE_GROUPS = 8
MOE_PER_GROUP = 8
MOE_EXPERTS = MOE_GROUPS * MOE_PER_GROUP
MOE_TOPK = 2
MOE_HIDDEN = D_MODEL // 2
MOE_BLOCK = 128
LN_EPS = 1e-5
DN_ALPHA = (2 * DEPTH) ** 0.25
DN_BETA = (8 * DEPTH) ** -0.25
N_ATTN_LAYERS = (DEPTH + 1) // 2
N_SG_LAYERS = DEPTH // 2

kernel_name = "hybrid_diffattn_gmlp_hmoe_deepnorm"


def layer_norm(x, g, b):
    xf = x.astype(jnp.float32)
    mu = jnp.mean(xf, axis=-1, keepdims=True)
    var = jnp.mean(jnp.square(xf - mu), axis=-1, keepdims=True)
    y = (xf - mu) * lax.rsqrt(var + LN_EPS)
    return (y * g.astype(jnp.float32) + b.astype(jnp.float32)).astype(x.dtype)


def rms_norm(x, g):
    xf = x.astype(jnp.float32)
    y = xf * lax.rsqrt(jnp.mean(jnp.square(xf), axis=-1, keepdims=True) + LN_EPS)
    return (y * g.astype(jnp.float32)).astype(x.dtype)


def t5_bucket(dist):
    n = jnp.maximum(dist, 0)
    max_exact = REL_BUCKETS // 2
    nf = jnp.maximum(n, 1).astype(jnp.float32)
    large = max_exact + (jnp.log(nf / max_exact) / math.log(REL_MAX_DIST / max_exact)
                         * (REL_BUCKETS - max_exact)).astype(jnp.int32)
    large = jnp.minimum(large, REL_BUCKETS - 1)
    return jnp.where(n < max_exact, n, large)


def diff_attention(x, w_in, w_out, lam_vecs, subln_g, rel_table, lam_init):
    B, S, _ = x.shape
    H, d = DA_HEADS, DA_HEAD_DIM
    qk_w = H * 2 * d
    qkv = x @ w_in
    q = qkv[..., :qk_w].reshape(B, S, H, 2, d).transpose(0, 2, 3, 1, 4) * (d ** -0.5)
    k = qkv[..., qk_w:2 * qk_w].reshape(B, S, H, 2, d).transpose(0, 2, 3, 1, 4)
    v = qkv[..., 2 * qk_w:].reshape(B, S, H, DA_VDIM).transpose(0, 2, 1, 3)
    lv = lam_vecs.astype(jnp.float32)
    lam = jnp.exp(jnp.sum(lv[0] * lv[1])) - jnp.exp(jnp.sum(lv[2] * lv[3])) + lam_init
    nq = S // Q_BLOCK
    q_blocks = jnp.moveaxis(q.reshape(B, H, 2, nq, Q_BLOCK, d), 3, 0)
    kpos = jnp.arange(S, dtype=jnp.int32)

    def block_fn(args):
        qb, i = args
        qpos = i * Q_BLOCK + jnp.arange(Q_BLOCK, dtype=jnp.int32)
        dist = qpos[:, None] - kpos[None, :]
        bias = jnp.transpose(rel_table[t5_bucket(dist)], (2, 0, 1))
        logits = jnp.einsum('bhmqd,bhmkd->bhmqk', qb, k).astype(jnp.float32)
        logits = logits + bias[None, :, None].astype(jnp.float32)
        logits = jnp.where((dist >= 0)[None, None, None], logits, -jnp.inf)
        p = jax.nn.softmax(logits, axis=-1)
        attn = p[:, :, 0] - lam * p[:, :, 1]
        return jnp.einsum('bhqk,bhke->bhqe', attn.astype(v.dtype), v)

    o = lax.map(block_fn, (q_blocks, jnp.arange(nq, dtype=jnp.int32)))
    o = jnp.moveaxis(o, 0, 2).reshape(B, H, S, DA_VDIM)
    o = rms_norm(o, subln_g) * (1.0 - lam_init)
    o = o.transpose(0, 2, 1, 3).reshape(B, S, H * DA_VDIM)
    return o @ w_out


def spatial_gating(x, w_in, b_in, ln_g, ln_b, w_s, b_s, w_out):
    B, S, _ = x.shape
    z = jax.nn.gelu(x @ w_in + b_in)
    u, v = z[..., :SG_HALF], z[..., SG_HALF:]
    v = layer_norm(v, ln_g, ln_b)
    nc = S // SG_CHUNK
    v = v.reshape(B, nc, SG_CHUNK, SG_GROUPS, SG_GROUP_DIM)
    causal = jnp.tril(jnp.ones((SG_CHUNK, SG_CHUNK), dtype=bool))
    w = jnp.where(causal[None], w_s, jnp.zeros_like(w_s))
    s = jnp.einsum('gts,bnsgc->bntgc', w, v) + jnp.transpose(b_s)[:, :, None]
    s = s.reshape(B, S, SG_HALF)
    return (u * s) @ w_out


def hier_moe(x, w_group, b_group, w_router, b_router, w_gate, w_up, w_down):
    B, S, D = x.shape
    N = B * S
    xt = x.reshape(N, D)
    g_logits = (xt @ w_group).astype(jnp.float32) + b_group.astype(jnp.float32)
    g_prob = jax.nn.softmax(g_logits, axis=-1)
    g_idx = jnp.argmax(g_logits, axis=-1).astype(jnp.int32)
    g_gate = jnp.take_along_axis(g_prob, g_idx[:, None], axis=-1)
    e_logits = ((xt @ w_router).astype(jnp.float32) + b_router.astype(jnp.float32))
    e_logits = e_logits.reshape(N, MOE_GROUPS, MOE_PER_GROUP)
    e_logits = jnp.take_along_axis(e_logits, g_idx[:, None, None], axis=1)[:, 0]
    top_val, top_idx = lax.top_k(e_logits, MOE_TOPK)
    gates = g_gate * jax.nn.softmax(top_val, axis=-1)
    expert = g_idx[:, None] * MOE_PER_GROUP + top_idx.astype(jnp.int32)

    A = N * MOE_TOPK
    a_exp = expert.reshape(A)
    a_tok = jnp.arange(A, dtype=jnp.int32) // MOE_TOPK
    a_gate = gates.reshape(A)
    order = jnp.argsort(a_exp)
    s_exp = a_exp[order]
    counts = jnp.zeros((MOE_EXPERTS,), jnp.int32).at[a_exp].add(1)
    padded = (counts + MOE_BLOCK - 1) // MOE_BLOCK * MOE_BLOCK
    starts = jnp.cumsum(counts) - counts
    pends = jnp.cumsum(padded)
    pstarts = pends - padded
    dest = pstarts[s_exp] + jnp.arange(A, dtype=jnp.int32) - starts[s_exp]
    n_blocks = -(-A // MOE_BLOCK) + MOE_EXPERTS
    P = n_blocks * MOE_BLOCK
    row_tok = jnp.full((P,), N, jnp.int32).at[dest].set(a_tok[order])
    row_gate = jnp.zeros((P,), jnp.float32).at[dest].set(a_gate[order])
    block_start = jnp.arange(n_blocks, dtype=jnp.int32) * MOE_BLOCK
    block_exp = jnp.minimum(jnp.searchsorted(pends, block_start, side='right'),
                            MOE_EXPERTS - 1).astype(jnp.int32)
    x_pad = jnp.concatenate([xt, jnp.zeros((1, D), xt.dtype)], axis=0)
    rows = x_pad[row_tok].reshape(n_blocks, MOE_BLOCK, D)

    def expert_block(args):
        r, e = args
        h = jax.nn.silu(r @ w_gate[e]) * (r @ w_up[e])
        return h @ w_down[e]

    y = lax.map(expert_block, (rows, block_exp)).reshape(P, D)
    out = jnp.zeros((N + 1, D), y.dtype).at[row_tok].add(y * row_gate[:, None].astype(y.dtype))
    return out[:N].reshape(B, S, D)


def setup_inputs(seed: int = 0) -> dict:
    key = jax.random.key(seed)
    ks = jax.random.split(key, 24)
    f32 = jnp.float32
    nrm = lambda k, shape, s: jax.random.normal(k, shape, f32) * s
    D, H, d = D_MODEL, DA_HEADS, DA_HEAD_DIM
    NA, NB, L = N_ATTN_LAYERS, N_SG_LAYERS, DEPTH
    return {
        "x": nrm(ks[0], (BATCH, SEQ, D), 1.0),
        "rel_bias": nrm(ks[1], (REL_BUCKETS, H), 0.5),
        "attn_w_in": nrm(ks[2], (NA, D, 2 * H * 2 * d + H * DA_VDIM), D ** -0.5),
        "attn_w_out": nrm(ks[3], (NA, H * DA_VDIM, D), (H * DA_VDIM) ** -0.5 * DN_BETA),
        "attn_lambda": nrm(ks[4], (NA, 4, d), 0.1),
        "attn_subln_g": 1.0 + nrm(ks[5], (NA, DA_VDIM), 0.02),
        "sg_w_in": nrm(ks[6], (NB, D, 2 * SG_HALF), D ** -0.5),
        "sg_b_in": nrm(ks[7], (NB, 2 * SG_HALF), 0.02),
        "sg_ln_g": 1.0 + nrm(ks[8], (NB, SG_HALF), 0.02),
        "sg_ln_b": nrm(ks[9], (NB, SG_HALF), 0.02),
        "sg_w_s": nrm(ks[10], (NB, SG_GROUPS, SG_CHUNK, SG_CHUNK), SG_CHUNK ** -0.5),
        "sg_b_s": 1.0 + nrm(ks[11], (NB, SG_GROUPS, SG_CHUNK), 0.1),
        "sg_w_out": nrm(ks[12], (NB, SG_HALF, D), SG_HALF ** -0.5 * DN_BETA),
        "moe_w_group": nrm(ks[13], (L, D, MOE_GROUPS), D ** -0.5),
        "moe_b_group": nrm(ks[14], (L, MOE_GROUPS), 0.01),
        "moe_w_router": nrm(ks[15], (L, D, MOE_EXPERTS), D ** -0.5),
        "moe_b_router": nrm(ks[16], (L, MOE_EXPERTS), 0.01),
        "moe_w_gate": nrm(ks[17], (L, MOE_EXPERTS, D, MOE_HIDDEN), D ** -0.5),
        "moe_w_up": nrm(ks[18], (L, MOE_EXPERTS, D, MOE_HIDDEN), D ** -0.5),
        "moe_w_down": nrm(ks[19], (L, MOE_EXPERTS, MOE_HIDDEN, D), MOE_HIDDEN ** -0.5 * DN_BETA),
        "ln_g": 1.0 + nrm(ks[20], (L, 2, D), 0.02),
        "ln_b": nrm(ks[21], (L, 2, D), 0.02),
    }


def reference(x, rel_bias, attn_w_in, attn_w_out, attn_lambda, attn_subln_g,
              sg_w_in, sg_b_in, sg_ln_g, sg_ln_b, sg_w_s, sg_b_s, sg_w_out,
              moe_w_group, moe_b_group, moe_w_router, moe_b_router,
              moe_w_gate, moe_w_up, moe_w_down, ln_g, ln_b):
    h = x
    for i in range(DEPTH):
        j = i // N_MIXERS
        if i % N_MIXERS == 0:
            lam_init = 0.8 - 0.6 * math.exp(-0.3 * i)
            mix = diff_attention(h, attn_w_in[j], attn_w_out[j], attn_lambda[j],
                                 attn_subln_g[j], rel_bias, lam_init)
        else:
            mix = spatial_gating(h, sg_w_in[j], sg_b_in[j], sg_ln_g[j], sg_ln_b[j],
                                 sg_w_s[j], sg_b_s[j], sg_w_out[j])
        h = layer_norm(DN_ALPHA * h + mix, ln_g[i, 0], ln_b[i, 0])
        ffn = hier_moe(h, moe_w_group[i], moe_b_group[i], moe_w_router[i], moe_b_router[i],
                       moe_w_gate[i], moe_w_up[i], moe_w_down[i])
        h = layer_norm(DN_ALPHA * h + ffn, ln_g[i, 1], ln_b[i, 1])
    return h
```

```cpp
#include <hip/hip_runtime.h>
#include <hip/hip_bf16.h>
#include <cstdio>
#include <cstdint>

#define LAS __attribute__((address_space(3)))
#define GAS __attribute__((address_space(1)))
typedef unsigned short bf16;
typedef short bf16x8 __attribute__((ext_vector_type(8)));
typedef short s16x4 __attribute__((ext_vector_type(4)));
typedef float f32x4 __attribute__((ext_vector_type(4)));
typedef float f32x2 __attribute__((ext_vector_type(2)));
typedef float f32x16 __attribute__((ext_vector_type(16)));
typedef unsigned u32x4 __attribute__((ext_vector_type(4)));
typedef unsigned u32x2 __attribute__((ext_vector_type(2)));
typedef LAS unsigned char lds_u8;

constexpr int D = 1024, BATCH = 16, SEQ = 4096, NTOK = BATCH * SEQ;
constexpr int NQKV = 3072, NHEAD = 8;
constexpr int SGH = 3072, SGG = 8, SGC = 128, SGGD = 384;
constexpr int NEXP = 64, MOEH = 512, NASG = NTOK * 2;
constexpr int PMAX = NASG + NEXP * 256;
constexpr float LN_EPS = 1e-5f, DN_ALPHA = 1.4142135623730951f;
constexpr float LOG2E = 1.4426950408889634f;
constexpr unsigned SRT_MARK = 0xFFFFFFFFu;
constexpr int NWAVES = 8, NTHREADS = 512, GRID = 256;

constexpr size_t MiB = 1u << 20;
constexpr size_t WS_CTL = 0, CTL_ZERO_BYTES = 1 * MiB;
constexpr size_t WS_DTAB = 1 * MiB;
constexpr size_t WS_WTRIL = 1 * MiB + 65536;
constexpr size_t WS_WR = 2 * MiB;
constexpr size_t WS_HIST = 3 * MiB;
constexpr size_t WS_AEXP = 4 * MiB;
constexpr size_t WS_AGATE = 5 * MiB;
constexpr size_t WS_SRT = 6 * MiB;
constexpr size_t WS_WQKV = 8 * MiB;
constexpr size_t WS_WO = 14 * MiB;
constexpr size_t WS_W1 = 16 * MiB;
constexpr size_t WS_W2 = 28 * MiB;
constexpr size_t WS_HB = 34 * MiB;
constexpr size_t WS_ARENA = 162 * MiB;
constexpr size_t WS_QKV = WS_ARENA;
constexpr size_t WS_OB = WS_ARENA + 384 * MiB;
constexpr size_t WS_YSLOT = WS_ARENA;
constexpr size_t WS_HM = WS_ARENA + 256 * MiB;
constexpr size_t WS_U = WS_ARENA;
constexpr size_t WS_V = WS_ARENA + 384 * MiB;
constexpr size_t WS_MOE1 = WS_ARENA + 576 * MiB;
constexpr size_t WS_MOE2 = WS_MOE1 + 128 * MiB;
constexpr size_t WS_END = WS_MOE2 + 64 * MiB;
static_assert(WS_HM + (size_t)PMAX * MOEH * 2 <= WS_MOE1, "ws map");
static_assert(WS_V + (size_t)NTOK * SGH * 2 <= WS_END, "ws map");

constexpr int RING_BYTES = 131072;
constexpr int LDSCTL_OFF = RING_BYTES;
constexpr int L_MISC = LDSCTL_OFF;
constexpr int L_CNT = LDSCTL_OFF + 64;
constexpr int L_PST = L_CNT + 256;
constexpr int L_OFFS = L_PST + 272;
constexpr int L_WCNT = L_OFFS + 256;
constexpr int L_PART = L_WCNT + 256;
constexpr int L_END = L_PART + 4096;
constexpr int LDS_BYTES = 147456;
static_assert(L_END <= LDS_BYTES, "LDS map");

__device__ __forceinline__ unsigned cvt_pk_bf16(float lo, float hi) { unsigned r; asm volatile("v_cvt_pk_bf16_f32 %0, %1, %2" : "=v"(r) : "v"(lo), "v"(hi)); return r; }
__device__ __forceinline__ float bf_lo(unsigned w) { return __uint_as_float(w << 16); }
__device__ __forceinline__ float bf_hi(unsigned w) { return __uint_as_float(w & 0xffff0000u); }
__device__ __forceinline__ float wave_sum(float v) {
#pragma unroll
    for (int o = 1; o < 64; o <<= 1) v += __shfl_xor(v, o);
    return v;
}
__device__ __forceinline__ float gelu_tanh(float x) {
    const float inner = x * (1.0f + 0.044715f * x * x);
    const float e = __builtin_amdgcn_exp2f(-2.302208198f * inner);
    return x * __builtin_amdgcn_rcpf(1.0f + e);
}
__device__ __forceinline__ float silu_f(float x) { return x * __builtin_amdgcn_rcpf(1.0f + __builtin_amdgcn_exp2f(-LOG2E * x)); }
__device__ __forceinline__ int tid_opaque() { int t = threadIdx.x; asm volatile("" : "+v"(t)); return t; }
#define LDS_WAIT() asm volatile("s_waitcnt lgkmcnt(0)" ::: "memory")
#define VM_WAIT() asm volatile("s_waitcnt vmcnt(0)" ::: "memory")

namespace pg8 {
constexpr int BM = 256, BK = 64, HALF = 128, HTB = HALF * BK * 2, STAGE_BYTES = 8 * HTB, NXCD = 8, WGM = 8;
__device__ __forceinline__ int lds_byte(int r, int c) { const int st = (r >> 4) * 2 + (c >> 5), rr = r & 15, cc = c & 31, ob = rr * 64 + cc * 2; return st * 1024 + (ob ^ (((ob >> 9) & 1) << 5)); }
__device__ __forceinline__ void stage_rc(int b, int& R, int& C) { const int st = b / 1024, sb = b % 1024, swz = sb ^ (((sb >> 9) & 1) << 5); R = (st >> 1) * 16 + swz / 64; C = (st & 1) * 32 + (swz % 64) / 2; }
__device__ __forceinline__ int perm32(int rho) { const int n = rho >> 4, i = rho & 15; return 8 * (i >> 2) + 4 * n + (i & 3); }

struct Unit { int pm, pn, e; };
struct Gemm { const bf16* A; const bf16* Bt; int K; size_t bstride; };

__device__ __forceinline__ bool static_tile(int i, int G, int c, int nM, int nN, int& pm, int& pn) {
    const int nwg = nM * nN; const long L = (long)i * G + c; if (L >= nwg) return false;
    int wgid = (int)L; { const int q = nwg / NXCD, r = nwg % NXCD, xcd = wgid % NXCD, off = wgid / NXCD; wgid = (xcd < r ? xcd * (q + 1) : r * (q + 1) + (xcd - r) * q) + off; }
    const int nig = WGM * nN, gid = wgid / nig, fm = gid * WGM, gsz = (nM - fm) < WGM ? (nM - fm) : WGM;
    pm = fm + ((wgid % nig) % gsz); pn = (wgid % nig) / gsz; return true;
}
struct StaticOrder {
    int nM, nN, G, c;
    __device__ __forceinline__ bool next(int i, Unit& u) const { u.e = 0; return static_tile(i, G, c, nM, nN, u.pm, u.pn); }
    __device__ __forceinline__ unsigned arow(const Unit& u, int r) const { return (unsigned)(u.pm * BM + r); }
};
struct SingleOrder {
    int pm;
    __device__ __forceinline__ bool next(int i, Unit& u) const { u.e = 0; u.pm = pm; u.pn = 0; return i == 0; }
    __device__ __forceinline__ unsigned arow(const Unit& u, int r) const { return (unsigned)(u.pm * BM + r); }
};
struct MoeOrder {
    int nM, G, c; const LAS int* pst; const unsigned* srt; bool gather;
    __device__ __forceinline__ bool next(int i, Unit& u) const {
        if (!static_tile(i, G, c, nM, 4, u.pm, u.pn)) return false;
        const int x = u.pm * BM, lane = tid_opaque() & 63;
        const int lo = pst[lane], hi = pst[lane + 1];
        const unsigned long long m = __ballot(lo <= x && x < hi);
        u.e = __builtin_amdgcn_readfirstlane(m ? __builtin_ctzll(m) : 0);
        return true;
    }
    __device__ __forceinline__ unsigned arow(const Unit& u, int r) const {
        if (!gather) return (unsigned)(u.pm * BM + r);
        const unsigned a = srt[u.pm * BM + r]; return a == SRT_MARK ? 0u : (a >> 1);
    }
};

template <int ACT> struct EpiBf16 {
    static constexpr bool PERM = true, AFTER_DRAIN = false;
    bf16* O; int ldc; const float* bias; int split_cols; size_t split_stride; float scale0;
    __device__ __forceinline__ void operator()(const f32x4 (&acc)[2][2][4][2], const Unit& u, int wr, int wc, int fr, int fq) const {
        const int row0 = u.pm * BM + wr * 64 + fr; int colt = u.pn * BM; bf16* base = O;
        float sc = 1.f; if (split_cols) { const int t = colt / split_cols; base += (size_t)t * split_stride; colt -= t * split_cols; if (t == 0) sc = scale0; }
        const int col0 = colt + wc * 32 + 8 * fq, bcol0 = u.pn * BM + wc * 32 + 8 * fq;
        f32x4 bv[2][2];
#pragma unroll
        for (int bj = 0; bj < 2; ++bj)
#pragma unroll
            for (int n = 0; n < 2; ++n) bv[bj][n] = bias ? *(const f32x4*)(bias + bcol0 + bj * HALF + 4 * n) : (f32x4){0.f, 0.f, 0.f, 0.f};
#pragma unroll
        for (int ai = 0; ai < 2; ++ai)
#pragma unroll
            for (int m = 0; m < 4; ++m) { bf16* rowp = base + (size_t)(row0 + ai * HALF + m * 16) * ldc + col0;
#pragma unroll
                for (int bj = 0; bj < 2; ++bj) { f32x4 v0 = acc[ai][bj][m][0] + bv[bj][0], v1 = acc[ai][bj][m][1] + bv[bj][1];
                    if (ACT == 1) {
#pragma unroll
                        for (int j = 0; j < 4; ++j) { v0[j] = gelu_tanh(v0[j]); v1[j] = gelu_tanh(v1[j]); } }
                    v0 = v0 * sc; v1 = v1 * sc; u32x4 w; w.x = cvt_pk_bf16(v0[0], v0[1]); w.y = cvt_pk_bf16(v0[2], v0[3]); w.z = cvt_pk_bf16(v1[0], v1[1]); w.w = cvt_pk_bf16(v1[2], v1[3]);
                    *(u32x4*)(rowp + bj * HALF) = w; } }
    }
};
struct EpiResF32 {
    static constexpr bool PERM = false, AFTER_DRAIN = false;
    const float* res; float* out; int ldc; float alpha;
    __device__ __forceinline__ void operator()(const f32x4 (&acc)[2][2][4][2], const Unit& u, int wr, int wc, int fr, int fq) const {
        const int col0 = u.pn * BM + wc * 32 + 4 * fq;
#pragma unroll
        for (int ai = 0; ai < 2; ++ai)
#pragma unroll
            for (int m = 0; m < 4; ++m) { const size_t off = (size_t)(u.pm * BM + ai * HALF + wr * 64 + m * 16 + fr) * ldc + col0;
#pragma unroll
                for (int bj = 0; bj < 2; ++bj)
#pragma unroll
                    for (int n = 0; n < 2; ++n) { const f32x4 r = *(const f32x4*)(res + off + bj * HALF + n * 16); *(f32x4*)(out + off + bj * HALF + n * 16) = r * alpha + acc[ai][bj][m][n]; } }
    }
};
struct EpiRouter {
    static constexpr bool PERM = false, AFTER_DRAIN = true;
    const float* bg; const float* br;
    __device__ __forceinline__ void fused(f32x4 (&acc)[2][2][4][2], const Unit& u, int wr, int wc, int fr, int fq, lds_u8* lds, int wid, int lane) const {
        LAS float* L = (LAS float*)lds;
        if (wc < 3) {
#pragma unroll
            for (int n = 0; n < 2; ++n) { const int c0 = wc * 32 + 16 * n + 4 * fq;
#pragma unroll
                for (int j = 0; j < 4; ++j) { const int c = c0 + j; if (c < 72) { const float b = c < 8 ? bg[c] : br[c - 8];
#pragma unroll
                    for (int ai = 0; ai < 2; ++ai)
#pragma unroll
                        for (int m = 0; m < 4; ++m) L[(ai * HALF + wr * 64 + m * 16 + fr) * 73 + c] = acc[ai][0][m][n][j] + b; } } } }
    }
};
struct EpiSwiglu {
    static constexpr bool PERM = true, AFTER_DRAIN = false;
    bf16* O;
    __device__ __forceinline__ void operator()(const f32x4 (&acc)[2][2][4][2], const Unit& u, int wr, int wc, int fr, int fq) const {
        const int col0 = u.pn * 128 + wc * 32 + 8 * fq;
#pragma unroll
        for (int ai = 0; ai < 2; ++ai)
#pragma unroll
            for (int m = 0; m < 4; ++m) { bf16* rowp = O + (size_t)(u.pm * BM + ai * HALF + wr * 64 + m * 16 + fr) * MOEH + col0;
                float o[8];
#pragma unroll
                for (int n = 0; n < 2; ++n)
#pragma unroll
                    for (int j = 0; j < 4; ++j) o[4 * n + j] = silu_f(acc[ai][0][m][n][j]) * acc[ai][1][m][n][j];
                u32x4 w; w.x = cvt_pk_bf16(o[0], o[1]); w.y = cvt_pk_bf16(o[2], o[3]); w.z = cvt_pk_bf16(o[4], o[5]); w.w = cvt_pk_bf16(o[6], o[7]);
                *(u32x4*)rowp = w; }
    }
};
struct EpiScatter {
    static constexpr bool PERM = true, AFTER_DRAIN = false;
    bf16* Y; const unsigned* srt; const float* gate;
    __device__ __forceinline__ void operator()(const f32x4 (&acc)[2][2][4][2], const Unit& u, int wr, int wc, int fr, int fq) const {
        const int col0 = u.pn * BM + wc * 32 + 8 * fq;
#pragma unroll
        for (int ai = 0; ai < 2; ++ai)
#pragma unroll
            for (int m = 0; m < 4; ++m) { const unsigned a = srt[u.pm * BM + ai * HALF + wr * 64 + m * 16 + fr];
                if (a != SRT_MARK) { const float gt = gate[a]; bf16* rowp = Y + (size_t)a * D + col0;
#pragma unroll
                    for (int bj = 0; bj < 2; ++bj) { const f32x4 v0 = acc[ai][bj][m][0] * gt, v1 = acc[ai][bj][m][1] * gt;
                        u32x4 w; w.x = cvt_pk_bf16(v0[0], v0[1]); w.y = cvt_pk_bf16(v0[2], v0[3]); w.z = cvt_pk_bf16(v1[0], v1[1]); w.w = cvt_pk_bf16(v1[2], v1[3]);
                        *(u32x4*)(rowp + bj * HALF) = w; } } }
    }
};

template <class Epi, class Sched, bool ALIGN_EPI, bool GATHER>
__device__ __forceinline__ void gemm_phase(lds_u8* lds, const Gemm g, const Sched& S, const Epi& E) {
    const int tid = tid_opaque(), wid = __builtin_amdgcn_readfirstlane(tid >> 6), lane = tid & 63, wr = wid >> 2, wc = wid & 3, fr = lane & 15, fq = lane >> 4;
    const int K = g.K, nt = K / BK;
    unsigned voffB[2], voffA[2]; int Rl[2], Cl[2];
#pragma unroll
    for (int i = 0; i < 2; ++i) { int R, C; stage_rc(tid * 16 + i * 8192, R, C); const int Rb = Epi::PERM ? ((R & ~31) + perm32(R & 31)) : R;
        Rl[i] = R; Cl[i] = C; voffA[i] = (unsigned)(R * K + C) * 2u; voffB[i] = (unsigned)(Rb * K + C) * 2u; }
    const size_t kstep = (size_t)(BK * 2);
    const size_t hstep = (size_t)HALF * K * 2;
    const size_t tstep = 2 * hstep;
    const unsigned ldsw = (unsigned)wid * 1024u;
    const int aoff = lds_byte(wr * 64 + fr, fq * 8), boff = lds_byte(wc * 32 + fr, fq * 8);
    const char* const Ab = (const char*)g.A;
#define PG8_SA(b, h) (((b) * 2 + (h)) * HTB)
#define PG8_SB(b, h) ((4 + (b) * 2 + (h)) * HTB)
#define PG8_STAGE_B(bufoff, gbase) do { _Pragma("unroll") for (int _i = 0; _i < 2; ++_i) \
        __builtin_amdgcn_global_load_lds((const unsigned*)((const char*)(gbase) + voffB[_i]), (LAS unsigned*)(lds + (bufoff) + ldsw + _i * 8192), 16, 0, 0); } while (0)
#define PG8_STAGE_A(bufoff, kb, ub, vo, h) do { _Pragma("unroll") for (int _i = 0; _i < 2; ++_i) { \
        const char* _src = GATHER ? (Ab + (kb) + (vo)[h][_i]) : ((ub) + (kb) + (size_t)(h) * hstep + voffA[_i]); \
        __builtin_amdgcn_global_load_lds((const unsigned*)_src, (LAS unsigned*)(lds + (bufoff) + ldsw + _i * 8192), 16, 0, 0); } } while (0)
#define PG8_LDA(dst, b, h) do { _Pragma("unroll") for (int m = 0; m < 4; ++m) _Pragma("unroll") for (int k = 0; k < 2; ++k) dst[m][k] = *(const LAS bf16x8*)(lds + PG8_SA(b, h) + aoff + m * 2048 + k * 1024); } while (0)
#define PG8_LDB(dst, b, h) do { _Pragma("unroll") for (int n = 0; n < 2; ++n) _Pragma("unroll") for (int k = 0; k < 2; ++k) dst[n][k] = *(const LAS bf16x8*)(lds + PG8_SB(b, h) + boff + n * 2048 + k * 1024); } while (0)
#define PG8_MMA(ai, bj, At, Bt) do { __builtin_amdgcn_s_setprio(1); _Pragma("unroll") for (int m = 0; m < 4; ++m) _Pragma("unroll") for (int n = 0; n < 2; ++n) _Pragma("unroll") for (int k = 0; k < 2; ++k) \
        acc[ai][bj][m][n] = __builtin_amdgcn_mfma_f32_16x16x32_bf16(Bt[n][k], At[m][k], acc[ai][bj][m][n], 0, 0, 0); __builtin_amdgcn_s_setprio(0); } while (0)
#define PG8_WAIT_V(n) asm volatile("s_waitcnt vmcnt(" #n ")" ::: "memory")
#define PG8_WAIT_L(n) asm volatile("s_waitcnt lgkmcnt(" #n ")" ::: "memory")
#define PG8_BAR __builtin_amdgcn_s_barrier()
#define PG8_SCHED __builtin_amdgcn_sched_barrier(0)
#define PG8_SETVO(vo, u) do { if constexpr (GATHER) { _Pragma("unroll") for (int _h = 0; _h < 2; ++_h) _Pragma("unroll") for (int _i = 0; _i < 2; ++_i) \
        (vo)[_h][_i] = (S.arow((u), _h * HALF + Rl[_i]) * (unsigned)K + (unsigned)Cl[_i]) * 2u; \
        asm volatile("" : "+v"((vo)[0][0]), "+v"((vo)[0][1]), "+v"((vo)[1][0]), "+v"((vo)[1][1])); } } while (0)
    Unit cur, nxt; int ui = 0;
    if (!S.next(0, cur)) return;
    unsigned voC[2][2], voN[2][2];
#pragma unroll
    for (int h = 0; h < 2; ++h)
#pragma unroll
        for (int i = 0; i < 2; ++i) { voC[h][i] = 0u; voN[h][i] = 0u; }
    PG8_SETVO(voC, cur);
    const char* cA = GATHER ? Ab : Ab + (size_t)cur.pm * tstep;
    f32x4 acc[2][2][4][2];
#pragma unroll
    for (int a = 0; a < 2; ++a)
#pragma unroll
        for (int b = 0; b < 2; ++b)
#pragma unroll
            for (int m = 0; m < 4; ++m)
#pragma unroll
                for (int n = 0; n < 2; ++n) acc[a][b][m][n] = (f32x4){0.f, 0.f, 0.f, 0.f};
    bf16x8 At[4][2], B0[2][2], B1[2][2];
    const char* cB = (const char*)g.Bt + (size_t)cur.e * g.bstride + (size_t)cur.pn * tstep;
    PG8_STAGE_B(PG8_SB(0, 0), cB); PG8_STAGE_B(PG8_SB(0, 1), cB + hstep); PG8_STAGE_A(PG8_SA(0, 0), 0, cA, voC, 0); PG8_STAGE_A(PG8_SA(0, 1), 0, cA, voC, 1);
    if (wr == 1) PG8_BAR;
    PG8_WAIT_V(2); PG8_BAR;
    PG8_STAGE_B(PG8_SB(1, 0), cB + kstep); PG8_STAGE_A(PG8_SA(1, 0), kstep, cA, voC, 0); PG8_STAGE_B(PG8_SB(1, 1), cB + hstep + kstep);
    PG8_WAIT_V(6); PG8_BAR;
    for (;;) {
        const bool has_next = S.next(ui + 1, nxt);
        if (has_next) { PG8_SETVO(voN, nxt); }
        else {
#pragma unroll
            for (int h = 0; h < 2; ++h)
#pragma unroll
                for (int i = 0; i < 2; ++i) voN[h][i] = voC[h][i]; }
        const char* nB = has_next ? (const char*)g.Bt + (size_t)nxt.e * g.bstride + (size_t)nxt.pn * tstep : cB;
        const char* nA = (has_next && !GATHER) ? Ab + (size_t)nxt.pm * tstep : cA;
        for (int t = 0; t < nt; t += 2) {
            const bool last = (t == nt - 2);
            const size_t k1 = (size_t)(t + 1) * kstep;
            const size_t k2 = last ? 0 : (size_t)(t + 2) * kstep, k3 = k2 + kstep; const char* u2 = last ? nA : cA;
            const char* b2 = last ? nB : cB + (size_t)(t + 2) * kstep;
            const char* b3 = b2 + kstep;
            unsigned vo2[2][2];
#pragma unroll
            for (int h = 0; h < 2; ++h)
#pragma unroll
                for (int i = 0; i < 2; ++i) vo2[h][i] = last ? voN[h][i] : voC[h][i];
            PG8_LDB(B0, 0, 0); PG8_LDB(B1, 0, 1); PG8_SCHED; PG8_LDA(At, 0, 0); PG8_STAGE_A(PG8_SA(1, 1), k1, cA, voC, 1);
            PG8_WAIT_V(8); PG8_WAIT_L(0); PG8_BAR; PG8_MMA(0, 0, At, B0); PG8_MMA(0, 1, At, B1); PG8_BAR; PG8_SCHED;
            PG8_LDA(At, 0, 1); PG8_STAGE_B(PG8_SB(0, 0), b2); PG8_STAGE_B(PG8_SB(0, 1), b2 + hstep); PG8_STAGE_A(PG8_SA(0, 0), k2, u2, vo2, 0);
            PG8_WAIT_V(8); PG8_WAIT_L(0); PG8_BAR; PG8_MMA(1, 0, At, B0); PG8_MMA(1, 1, At, B1); PG8_BAR; PG8_SCHED;
            PG8_LDB(B0, 1, 0); PG8_LDB(B1, 1, 1); PG8_SCHED; PG8_LDA(At, 1, 0); PG8_STAGE_A(PG8_SA(0, 1), k2, u2, vo2, 1);
            PG8_WAIT_V(8); PG8_WAIT_L(0); PG8_BAR; PG8_MMA(0, 0, At, B0); PG8_MMA(0, 1, At, B1); PG8_BAR; PG8_SCHED;
            PG8_LDA(At, 1, 1); PG8_STAGE_B(PG8_SB(1, 0), b3); PG8_STAGE_B(PG8_SB(1, 1), b3 + hstep); PG8_STAGE_A(PG8_SA(1, 0), k3, u2, vo2, 0);
            PG8_WAIT_V(8); PG8_WAIT_L(0); PG8_BAR; PG8_MMA(1, 0, At, B0); PG8_MMA(1, 1, At, B1); PG8_BAR; PG8_SCHED;
        }
        if constexpr (ALIGN_EPI) { if (wr == 0) PG8_BAR; }
        if constexpr (!Epi::AFTER_DRAIN) { E(acc, cur, wr, wc, fr, fq); }
        if (!has_next) break;
#pragma unroll
        for (int a = 0; a < 2; ++a)
#pragma unroll
            for (int b = 0; b < 2; ++b)
#pragma unroll
                for (int m = 0; m < 4; ++m)
#pragma unroll
                    for (int n = 0; n < 2; ++n) acc[a][b][m][n] = (f32x4){0.f, 0.f, 0.f, 0.f};
        cur = nxt; cB = nB; cA = nA; ++ui;
#pragma unroll
        for (int h = 0; h < 2; ++h)
#pragma unroll
            for (int i = 0; i < 2; ++i) voC[h][i] = voN[h][i];
        if constexpr (ALIGN_EPI) { if (wr == 1) PG8_BAR; }
    }
    PG8_WAIT_V(0);
    if constexpr (!ALIGN_EPI) { if (wr == 0) PG8_BAR; }
    PG8_BAR;
    if constexpr (Epi::AFTER_DRAIN) { E.fused(acc, cur, wr, wc, fr, fq, lds, wid, lane); }
#undef PG8_SA
#undef PG8_SB
#undef PG8_STAGE_A
#undef PG8_STAGE_B
#undef PG8_LDA
#undef PG8_LDB
#undef PG8_MMA
#undef PG8_WAIT_V
#undef PG8_WAIT_L
#undef PG8_BAR
#undef PG8_SCHED
#undef PG8_SETVO
}
}

namespace da {
constexpr int QBLK = 32, KVBLK = 64, LDQ = NQKV;
constexpr int SHM_V = KVBLK * 128 * 2, SHM_K = KVBLK * 64 * 2;
constexpr int L_V = 0, L_K = 2 * SHM_V, L_WS = L_K + 2 * SHM_K, L_TAB = L_WS + NWAVES * 64 * 4, L_STASH = L_TAB + 640 * 4, L_ENDA = L_STASH + NWAVES * 32 * 64 * 4;
static_assert(L_ENDA <= RING_BYTES && (L_STASH % 16) == 0, "attention LDS map");
constexpr float THR = 8.f;
#define SBAR() __builtin_amdgcn_sched_barrier(0)
#define KSWZ64(row, colB) ((row) * 128 + ((colB) ^ ((((row) >> 1) & 7) << 4)))
__device__ __forceinline__ int crow(int r, int hi) { return (r & 3) + 8 * (r >> 2) + 4 * hi; }

__device__ __forceinline__ void partialSM(f32x16& p0, f32x16& p1, float& m_reg, float& alpha) {
    float pmax = p0[0];
#pragma unroll
    for (int r = 1; r < 16; ++r) pmax = fmaxf(pmax, p0[r]);
#pragma unroll
    for (int r = 0; r < 16; ++r) pmax = fmaxf(pmax, p1[r]);
    { auto rr = __builtin_amdgcn_permlane32_swap(__float_as_uint(pmax), __float_as_uint(pmax), false, false);
      pmax = fmaxf(__uint_as_float(rr[0]), __uint_as_float(rr[1])); }
    float mn;
    if (__builtin_expect(__all(pmax - m_reg <= THR), 1)) { mn = m_reg; alpha = 1.f; }
    else { mn = fmaxf(m_reg, pmax); alpha = __builtin_amdgcn_exp2f(m_reg - mn); m_reg = mn; }
#pragma unroll
    for (int r = 0; r < 16; ++r) p0[r] = p0[r] - mn;
#pragma unroll
    for (int r = 0; r < 16; ++r) p1[r] = p1[r] - mn;
#pragma unroll
    for (int r = 0; r < 16; ++r) p0[r] = __builtin_amdgcn_exp2f(p0[r]);
}
__device__ __forceinline__ void finishSM(f32x16& p0, f32x16& p1, float alpha, float& l_reg, bf16x8& pa0, bf16x8& pa1, bf16x8& pa2, bf16x8& pa3) {
#pragma unroll
    for (int r = 0; r < 16; ++r) p1[r] = __builtin_amdgcn_exp2f(p1[r]);
    float ps = 0;
#pragma unroll
    for (int r = 0; r < 16; ++r) ps += p0[r];
#pragma unroll
    for (int r = 0; r < 16; ++r) ps += p1[r];
    { auto rr = __builtin_amdgcn_permlane32_swap(__float_as_uint(ps), __float_as_uint(ps), false, false);
      ps = __uint_as_float(rr[0]) + __uint_as_float(rr[1]); }
    l_reg = l_reg * alpha + ps;
#define PK4(P, BASE, OUT) do { unsigned a0 = cvt_pk_bf16(P[BASE + 0], P[BASE + 1]), a1 = cvt_pk_bf16(P[BASE + 2], P[BASE + 3]);   \
    unsigned b0 = cvt_pk_bf16(P[BASE + 4], P[BASE + 5]), b1 = cvt_pk_bf16(P[BASE + 6], P[BASE + 7]);                              \
    auto r0 = __builtin_amdgcn_permlane32_swap(a0, b0, false, false); auto r1 = __builtin_amdgcn_permlane32_swap(a1, b1, false, false); \
    u32x4 w = {r0[0], r1[0], r0[1], r1[1]}; OUT = __builtin_bit_cast(bf16x8, w); } while (0)
    PK4(p0, 0, pa0); PK4(p0, 8, pa1); PK4(p1, 0, pa2); PK4(p1, 8, pa3);
#undef PK4
}
__device__ __forceinline__ void qkt(f32x16& p0, f32x16& p1, const LAS char* Ks, const bf16x8* qr, int r32, int hi) {
    p0 = f32x16{}; p1 = f32x16{};
#pragma unroll
    for (int d0 = 0; d0 < 4; ++d0) { const int cb = (d0 * 16 + hi * 8) * 2;
        const bf16x8 b0 = *(const LAS bf16x8*)(Ks + KSWZ64(r32, cb));
        const bf16x8 b1 = *(const LAS bf16x8*)(Ks + KSWZ64(32 + r32, cb));
        p0 = __builtin_amdgcn_mfma_f32_32x32x16_bf16(b0, qr[d0], p0, 0, 0, 0);
        p1 = __builtin_amdgcn_mfma_f32_32x32x16_bf16(b1, qr[d0], p1, 0, 0, 0); }
}
__device__ __forceinline__ int v_st(int k, int c) { const int kk = (k & ~0xC) | ((k & 4) << 1) | ((k & 8) >> 1); return ((kk >> 3) * 4 + (c >> 5)) * 512 + ((kk & 7) * 32 + (c & 31)) * 2; }
__device__ __forceinline__ int v_rd_base(int lane) { return ((lane & 3) << 3) | (((lane >> 2) & 3) << 6) | (((lane >> 4) & 1) << 5) | (((lane >> 5) & 1) << 8); }
constexpr int v_rd_off(int d0, int ks, int half) { return d0 * 512 + ks * 4096 + half * 2048; }
template <int OFF> __device__ __forceinline__ s16x4 tr_read(int vb) {
    s16x4 r; asm volatile("ds_read_b64_tr_b16 %0, %1 offset:%2" : "=&v"(r) : "v"(vb), "i"(OFF) : "memory"); return r;
}
template <int D0> __device__ __forceinline__ void pv_one(f32x16& od, int vb, bf16x8 pa0, bf16x8 pa1, bf16x8 pa2, bf16x8 pa3) {
    const s16x4 l0 = tr_read<v_rd_off(D0, 0, 0)>(vb), h0 = tr_read<v_rd_off(D0, 0, 1)>(vb), l1 = tr_read<v_rd_off(D0, 1, 0)>(vb), h1 = tr_read<v_rd_off(D0, 1, 1)>(vb);
    const s16x4 l2 = tr_read<v_rd_off(D0, 2, 0)>(vb), h2 = tr_read<v_rd_off(D0, 2, 1)>(vb), l3 = tr_read<v_rd_off(D0, 3, 0)>(vb), h3 = tr_read<v_rd_off(D0, 3, 1)>(vb);
    asm volatile("s_waitcnt lgkmcnt(0)" ::: "memory"); SBAR();
#define PK(L, H) (bf16x8){L[0], L[1], L[2], L[3], H[0], H[1], H[2], H[3]}
    od = __builtin_amdgcn_mfma_f32_32x32x16_bf16(pa0, PK(l0, h0), od, 0, 0, 0);
    od = __builtin_amdgcn_mfma_f32_32x32x16_bf16(pa1, PK(l1, h1), od, 0, 0, 0);
    od = __builtin_amdgcn_mfma_f32_32x32x16_bf16(pa2, PK(l2, h2), od, 0, 0, 0);
    od = __builtin_amdgcn_mfma_f32_32x32x16_bf16(pa3, PK(l3, h3), od, 0, 0, 0);
#undef PK
}
__device__ __forceinline__ void pv_d0(f32x16* o, int vb, bf16x8 pa0, bf16x8 pa1, bf16x8 pa2, bf16x8 pa3) {
    pv_one<0>(o[0], vb, pa0, pa1, pa2, pa3); pv_one<1>(o[1], vb, pa0, pa1, pa2, pa3); pv_one<2>(o[2], vb, pa0, pa1, pa2, pa3); pv_one<3>(o[3], vb, pa0, pa1, pa2, pa3);
}
__device__ __forceinline__ void biasmask(f32x16& p0, f32x16& p1, int base, int hi, const LAS float* tab) {
    const LAS float* tp = tab + (base + 256 - 4 * hi - 59);
    const int bl = base - 4 * hi;
#pragma unroll
    for (int r = 0; r < 16; ++r) { const int kk = (r & 3) + 8 * (r >> 2);
        p0[r] = (kk > bl) ? -INFINITY : p0[r] + tp[59 - kk];
        p1[r] = (kk + 32 > bl) ? -INFINITY : p1[r] + tp[59 - 32 - kk]; }
}

__device__ __forceinline__ void flash_pass(f32x16 (&o)[4], const bf16* __restrict__ Qw, const bf16* __restrict__ Kh, const bf16* __restrict__ Vh,
                                           int NT, int qabs, lds_u8* lds) {
    const int tid = tid_opaque(), wid = tid >> 6, lane = tid & 63, r32 = lane & 31, hi = lane >> 5;
    LAS char* V_lds = (LAS char*)(lds + L_V); LAS char* K_lds = (LAS char*)(lds + L_K);
    LAS float* ws = (LAS float*)(lds + L_WS) + wid * 64; LAS float* li_l = ws; LAS float* al_l = ws + 32;
    const LAS float* tab = (const LAS float*)(lds + L_TAB);
    float m_reg = -1e30f, l_reg = 0.f; bf16x8 qr[4];
#pragma unroll
    for (int d0 = 0; d0 < 4; ++d0) { o[d0] = f32x16{}; qr[d0] = *(const bf16x8*)(Qw + d0 * 16); }
    const int sr = tid >> 4, sc = (tid & 15) * 8, vst0 = v_st(sr, sc), vst1 = v_st(32 + sr, sc);
    const int kr = tid >> 3, kc = (tid & 7) * 8, kst = KSWZ64(kr, kc * 2);
    const int vb0 = (int)(uintptr_t)V_lds + v_rd_base(lane);
    struct { bf16x8 vs0, vs1, ks; } sr_[2];
#define SLOAD(i, k0) do { sr_[i].vs0 = *(const bf16x8*)(&Vh[(long)((k0) + sr) * LDQ + sc]); sr_[i].vs1 = *(const bf16x8*)(&Vh[(long)((k0) + 32 + sr) * LDQ + sc]); \
    sr_[i].ks = *(const bf16x8*)(&Kh[(long)((k0) + kr) * LDQ + kc]); } while (0)
#define SWRITE(b, i) do { *(LAS bf16x8*)(V_lds + (b) * SHM_V + vst0) = sr_[i].vs0; *(LAS bf16x8*)(V_lds + (b) * SHM_V + vst1) = sr_[i].vs1; \
    *(LAS bf16x8*)(K_lds + (b) * SHM_K + kst) = sr_[i].ks; } while (0)
#define SWAIT() asm volatile("s_waitcnt vmcnt(3)" ::: "memory")
#define RESC(a) do { if (__any((a) < 1.f)) { if (hi == 0) al_l[r32] = (a); asm volatile("s_waitcnt lgkmcnt(0)" ::: "memory"); \
    _Pragma("unroll") for (int d = 0; d < 4; ++d) _Pragma("unroll") for (int r = 0; r < 16; ++r) o[d][r] *= al_l[crow(r, hi)]; } } while (0)
#define BMASK(P0, P1, j) do { if ((j) >= NT - 6) biasmask(P0, P1, qabs - 64 * (j), hi, tab); } while (0)
    f32x16 pA0, pA1, pB0, pB1; float alA, alB; bf16x8 pa0, pa1, pa2, pa3;
    SLOAD(0, 0); asm volatile("s_waitcnt vmcnt(0)" ::: "memory"); SWRITE(0, 0); __syncthreads();
    qkt(pA0, pA1, K_lds, qr, r32, hi); BMASK(pA0, pA1, 0); partialSM(pA0, pA1, m_reg, alA);
    SLOAD(1, KVBLK); if (2 < NT) SLOAD(0, 2 * KVBLK);
    SWAIT(); SWRITE(1, 1); __syncthreads();
    for (int j = 1; j + 1 < NT; j += 2) {
        SBAR(); qkt(pB0, pB1, K_lds + SHM_K, qr, r32, hi);
        finishSM(pA0, pA1, alA, l_reg, pa0, pa1, pa2, pa3); SBAR();
        SLOAD(1, (j + 2) * KVBLK); SBAR();
        pv_d0(o, vb0, pa0, pa1, pa2, pa3); BMASK(pB0, pB1, j); partialSM(pB0, pB1, m_reg, alB);
        __syncthreads(); SWAIT(); SWRITE(0, 0);
        RESC(alB); __syncthreads();
        SBAR(); qkt(pA0, pA1, K_lds, qr, r32, hi);
        finishSM(pB0, pB1, alB, l_reg, pa0, pa1, pa2, pa3); SBAR();
        if (j + 3 < NT) SLOAD(0, (j + 3) * KVBLK); SBAR();
        pv_d0(o, vb0 + SHM_V, pa0, pa1, pa2, pa3); BMASK(pA0, pA1, j + 1); partialSM(pA0, pA1, m_reg, alA);
        __syncthreads(); SWAIT(); SWRITE(1, 1);
        RESC(alA); __syncthreads();
    }
    SBAR(); qkt(pB0, pB1, K_lds + SHM_K, qr, r32, hi);
    finishSM(pA0, pA1, alA, l_reg, pa0, pa1, pa2, pa3); SBAR();
    pv_d0(o, vb0, pa0, pa1, pa2, pa3); BMASK(pB0, pB1, NT - 1); partialSM(pB0, pB1, m_reg, alB);
    __syncthreads(); RESC(alB);
    finishSM(pB0, pB1, alB, l_reg, pa0, pa1, pa2, pa3); SBAR();
    pv_d0(o, vb0 + SHM_V, pa0, pa1, pa2, pa3);
    if (hi == 0) li_l[r32] = l_reg; asm volatile("s_waitcnt lgkmcnt(0)" ::: "memory");
#pragma unroll
    for (int r = 0; r < 16; ++r) { const float rl = __builtin_amdgcn_rcpf(li_l[crow(r, hi)]);
#pragma unroll
        for (int d = 0; d < 4; ++d) o[d][r] *= rl; }
    __syncthreads();
#undef SLOAD
#undef SWRITE
#undef SWAIT
#undef RESC
#undef BMASK
}

__device__ __forceinline__ void attn_unit(int b, int h, int qt, const bf16* qkv, bf16* ob, const float* dtab, const float* subg, float lam, lds_u8* lds) {
    const int tid = tid_opaque(), wid = tid >> 6, lane = tid & 63, r32 = lane & 31, hi = lane >> 5;
    LAS float* tab = (LAS float*)(lds + L_TAB);
    for (int i = tid; i < 640; i += NTHREADS) { const int d = i - 256; tab[i] = (d >= 0 && d < 128) ? dtab[h * 128 + d] : 0.f; }
    __syncthreads();
    const long rowbase = (long)b * SEQ; const int q0 = qt * 256; const int NT = 4 * qt + 4;
    const int qabs = q0 + wid * QBLK + r32;
    LAS unsigned* stash = (LAS unsigned*)(lds + L_STASH) + wid * (32 * 64) + lane;
    f32x16 o[4];
    { const bf16* Qw = qkv + (rowbase + qabs) * LDQ + h * 128 + hi * 8;
      const bf16* Kh = qkv + rowbase * LDQ + 1024 + h * 128;
      const bf16* Vh = qkv + rowbase * LDQ + 2048 + h * 128;
      flash_pass(o, Qw, Kh, Vh, NT, qabs, lds);
#pragma unroll
      for (int r = 0; r < 16; ++r) { stash[(2 * r) * 64] = cvt_pk_bf16(o[0][r], o[1][r]); stash[(2 * r + 1) * 64] = cvt_pk_bf16(o[2][r], o[3][r]); } }
    { const bf16* Qw = qkv + (rowbase + qabs) * LDQ + h * 128 + 64 + hi * 8;
      const bf16* Kh = qkv + rowbase * LDQ + 1024 + h * 128 + 64;
      const bf16* Vh = qkv + rowbase * LDQ + 2048 + h * 128;
      flash_pass(o, Qw, Kh, Vh, NT, qabs, lds); }
    LDS_WAIT();
    float gsc[4];
#pragma unroll
    for (int d = 0; d < 4; ++d) gsc[d] = subg[32 * d + r32] * 0.8f;
#pragma unroll
    for (int r = 0; r < 16; ++r) {
        const unsigned w0 = stash[(2 * r) * 64], w1 = stash[(2 * r + 1) * 64];
        const float v0 = bf_lo(w0) - lam * o[0][r], v1 = bf_hi(w0) - lam * o[1][r], v2 = bf_lo(w1) - lam * o[2][r], v3 = bf_hi(w1) - lam * o[3][r];
        float ss = (v0 * v0 + v1 * v1) + (v2 * v2 + v3 * v3);
        ss += __shfl_xor(ss, 1); ss += __shfl_xor(ss, 2); ss += __shfl_xor(ss, 4); ss += __shfl_xor(ss, 8); ss += __shfl_xor(ss, 16);
        const float rs = 1.0f / sqrtf(ss * (1.0f / 128.0f) + LN_EPS);
        bf16* op = ob + (rowbase + q0 + wid * QBLK + crow(r, hi)) * D + h * 128 + r32;
        op[0] = (bf16)(cvt_pk_bf16(v0 * rs * gsc[0], 0.f) & 0xffffu); op[32] = (bf16)(cvt_pk_bf16(v1 * rs * gsc[1], 0.f) & 0xffffu);
        op[64] = (bf16)(cvt_pk_bf16(v2 * rs * gsc[2], 0.f) & 0xffffu); op[96] = (bf16)(cvt_pk_bf16(v3 * rs * gsc[3], 0.f) & 0xffffu);
    }
    __syncthreads();
}
}

namespace sg {
constexpr int L_VT = 0;
constexpr int L_ST = 65536;
__device__ __forceinline__ void chunk_unit(int ch, bf16* U, const bf16* V, const float* lng, const float* lnb, const bf16* wtril, const float* bs, lds_u8* lds) {
    const int tid = tid_opaque(), wid = tid >> 6, lane = tid & 63, r32 = lane & 31, hi = lane >> 5;
    const long R0 = (long)ch * SGC;
    LAS float* st = (LAS float*)(lds + L_ST);
    for (int i = 0; i < 16; ++i) { const int row = wid * 16 + i; const bf16* vr = V + (R0 + row) * SGH + lane * 8;
        float s = 0.f, q = 0.f;
#pragma unroll
        for (int j = 0; j < 6; ++j) { const u32x4 w = *(const u32x4*)(vr + j * 512);
#pragma unroll
            for (int k = 0; k < 4; ++k) { const float a = bf_lo(w[k]), b = bf_hi(w[k]); s += a + b; q += a * a + b * b; } }
        s = wave_sum(s); q = wave_sum(q);
        const float mu = s * (1.0f / SGH); const float var = fmaxf(q * (1.0f / SGH) - mu * mu, 0.f);
        if (lane == 0) { st[row * 2] = mu; st[row * 2 + 1] = 1.0f / sqrtf(var + LN_EPS); } }
    __syncthreads();
    const int sr = tid >> 4, sc = (tid & 15) * 8;
    const int rb = wid & 3, chh = wid >> 2;
    for (int sl = 0; sl < 24; ++sl) {
        const int g = sl / 3, c0 = sl * 128; const int buf = sl & 1;
        LAS char* vt = (LAS char*)(lds + L_VT + buf * 32768);
        { f32x4 ga = *(const f32x4*)(lng + c0 + sc), gb = *(const f32x4*)(lng + c0 + sc + 4), ba = *(const f32x4*)(lnb + c0 + sc), bb = *(const f32x4*)(lnb + c0 + sc + 4);
#pragma unroll
          for (int i = 0; i < 4; ++i) { const int row = sr + 32 * i; const u32x4 w = *(const u32x4*)(V + (R0 + row) * SGH + c0 + sc);
              const float mu = st[row * 2], rs = st[row * 2 + 1];
              u32x4 o;
              o.x = cvt_pk_bf16((bf_lo(w.x) - mu) * rs * ga[0] + ba[0], (bf_hi(w.x) - mu) * rs * ga[1] + ba[1]);
              o.y = cvt_pk_bf16((bf_lo(w.y) - mu) * rs * ga[2] + ba[2], (bf_hi(w.y) - mu) * rs * ga[3] + ba[3]);
              o.z = cvt_pk_bf16((bf_lo(w.z) - mu) * rs * gb[0] + bb[0], (bf_hi(w.z) - mu) * rs * gb[1] + bb[1]);
              o.w = cvt_pk_bf16((bf_lo(w.w) - mu) * rs * gb[2] + bb[2], (bf_hi(w.w) - mu) * rs * gb[3] + bb[3]);
              *(LAS u32x4*)(vt + (row >> 6) * 16384 + da::v_st(row & 63, sc)) = o; } }
        __syncthreads();
        f32x16 o0 = f32x16{}, o1 = f32x16{};
        const bf16* wrow = wtril + ((size_t)g * 128 + rb * 32 + r32) * 128 + hi * 8;
        const int vb = (int)(uintptr_t)vt + da::v_rd_base(lane);
#pragma unroll
        for (int kt = 0; kt < 2; ++kt) {
            if (kt == 0 || rb >= 2) {
                const bf16x8 pa0 = *(const bf16x8*)(wrow + kt * 64), pa1 = *(const bf16x8*)(wrow + kt * 64 + 16), pa2 = *(const bf16x8*)(wrow + kt * 64 + 32), pa3 = *(const bf16x8*)(wrow + kt * 64 + 48);
                if (chh == 0) { da::pv_one<0>(o0, vb + kt * 16384, pa0, pa1, pa2, pa3); da::pv_one<1>(o1, vb + kt * 16384, pa0, pa1, pa2, pa3); }
                else          { da::pv_one<2>(o0, vb + kt * 16384, pa0, pa1, pa2, pa3); da::pv_one<3>(o1, vb + kt * 16384, pa0, pa1, pa2, pa3); }
            }
        }
#pragma unroll
        for (int r = 0; r < 16; ++r) { const int t = rb * 32 + da::crow(r, hi); const float bt = bs[g * 128 + t];
            bf16* up = U + (R0 + t) * SGH + c0 + chh * 64 + r32;
            const float u0 = __uint_as_float((unsigned)up[0] << 16), u1 = __uint_as_float((unsigned)up[32] << 16);
            up[0] = (bf16)(cvt_pk_bf16(u0 * (o0[r] + bt), 0.f) & 0xffffu); up[32] = (bf16)(cvt_pk_bf16(u1 * (o1[r] + bt), 0.f) & 0xffffu); }
    }
    __syncthreads();
}
}

#define XB_TMO      128
#define XB_XCNT(j)  (256  + 64 * (j))
#define XB_XSUB(j)  (1280 + 64 * (j))
#define XB_XGEN(j)  (2304 + 64 * (j))
#define XB_TOP      3328
#define XB_TOPGEN   3392
#define XCD_BAR_WORDS 3456
#define XB_SPIN_CAP (1u << 22)
__device__ __forceinline__ unsigned xb_ld(unsigned* p)              { return __hip_atomic_load(p, __ATOMIC_RELAXED, __HIP_MEMORY_SCOPE_AGENT); }
__device__ __forceinline__ unsigned xb_add(unsigned* p, unsigned v) { return __hip_atomic_fetch_add(p, v, __ATOMIC_RELAXED, __HIP_MEMORY_SCOPE_AGENT); }
__device__ __forceinline__ unsigned xb_xcc_id() { return (unsigned)__builtin_amdgcn_s_getreg((3 << 11) | 20) & 0xFu; }
#define XB_SPIN(cond, bar) do { unsigned _sp = 0; while (cond) { __builtin_amdgcn_s_sleep(1); \
    if ((++_sp & 255u) == 0u) { if (xb_ld(&(bar)[XB_TMO])) break; if (_sp > XB_SPIN_CAP) { atomicAdd(&(bar)[XB_TMO], 1u); break; } } } } while (0)
struct XcdBarrier { unsigned* bar; unsigned x; volatile LAS unsigned* st; };
__device__ __forceinline__ XcdBarrier xcd_barrier_post(unsigned* bar, volatile LAS unsigned* st) {
    XcdBarrier b; b.bar = bar; b.x = xb_xcc_id(); b.st = st;
    if (threadIdx.x == 0) (void)xb_add(&bar[XB_XCNT(b.x)], 1u);
    return b;
}
__device__ __forceinline__ void xcd_barrier_complete(unsigned* bar, unsigned x, unsigned& nloc, unsigned& nx) {
    const unsigned G = gridDim.x * gridDim.y * gridDim.z;
    unsigned sum, cnt, mine, sp = 0u;
    for (;;) {
        sum = 0u; cnt = 0u; mine = 0u;
#pragma unroll
        for (unsigned j = 0; j < 16; ++j) { const unsigned c = xb_ld(&bar[XB_XCNT(j)]); sum += c; cnt += (c > 0u) ? 1u : 0u; mine = (j == x) ? c : mine; }
        if (sum == G) break;
        __builtin_amdgcn_s_sleep(1);
        if ((++sp & 255u) == 0u) { if (xb_ld(&bar[XB_TMO])) break; if (sp > XB_SPIN_CAP) { atomicAdd(&bar[XB_TMO], 1u); break; } }
    }
    nloc = mine > 0u ? mine : 1u; nx = cnt > 0u ? cnt : 1u;
}
__device__ __forceinline__ void xcd_barrier(const XcdBarrier& b) {
    asm volatile("s_waitcnt vmcnt(0)" ::: "memory");
    __syncthreads();
    if (threadIdx.x == 0) {
        unsigned* bar = b.bar;
        __builtin_amdgcn_s_waitcnt(0);
        unsigned nloc = b.st[0], nx = b.st[1];
        if (nloc == 0u) { xcd_barrier_complete(bar, b.x, nloc, nx); b.st[0] = nloc; b.st[1] = nx; }
        const unsigned old = xb_add(&bar[XB_XSUB(b.x)], 1u);
        const unsigned gen = old / nloc;
        if (old + 1u == (gen + 1u) * nloc) {
            __builtin_amdgcn_fence(__ATOMIC_RELEASE, "agent");
            asm volatile("s_waitcnt vmcnt(0)" ::: "memory");
            const unsigned og = xb_add(&bar[XB_TOP], 1u);
            const unsigned tg = og / nx;
            if (og + 1u == (tg + 1u) * nx) xb_add(&bar[XB_TOPGEN], 1u);
            else XB_SPIN(xb_ld(&bar[XB_TOPGEN]) == tg, bar);
            __builtin_amdgcn_fence(__ATOMIC_ACQUIRE, "agent");
            xb_add(&bar[XB_XGEN(b.x)], 1u);
            asm volatile("s_waitcnt vmcnt(0)" ::: "memory");
        } else {
            XB_SPIN(xb_ld(&bar[XB_XGEN(b.x)]) == gen, bar);
            __builtin_amdgcn_fence(__ATOMIC_ACQUIRE, "agent");
            asm volatile("s_waitcnt vmcnt(0)" ::: "memory");
        }
    }
    __syncthreads();
}

__device__ __forceinline__ void transpose_item(const float* W, int N, bf16* WT, int ldk, int row_off, int k0, int n0, LAS float* scr, int lane) {
#pragma unroll 8
    for (int i = 0; i < 32; ++i) { const int kk = 2 * i + (lane >> 5); scr[kk * 33 + (lane & 31)] = W[(size_t)(k0 + kk) * N + n0 + (lane & 31)]; }
    LDS_WAIT(); asm volatile("" ::: "memory");
    const int c = lane & 7;
#pragma unroll
    for (int j = 0; j < 4; ++j) { const int n = (lane >> 3) + 8 * j; const LAS float* s = scr + (8 * c) * 33 + n;
        u32x4 o; o.x = cvt_pk_bf16(s[0 * 33], s[1 * 33]); o.y = cvt_pk_bf16(s[2 * 33], s[3 * 33]); o.z = cvt_pk_bf16(s[4 * 33], s[5 * 33]); o.w = cvt_pk_bf16(s[6 * 33], s[7 * 33]);
        *(u32x4*)(WT + (size_t)(row_off + n) * ldk + k0 + 8 * c) = o; }
    LDS_WAIT(); asm volatile("" ::: "memory");
}
__device__ __forceinline__ void transpose_matrix(const float* W, int K, int N, bf16* WT, LAS float* scr, int gw, int ngw, int lane) {
    const int nblk = N / 32, nitems = (K / 64) * nblk;
    for (int it = gw; it < nitems; it += ngw) { const int kb = it / nblk, nb = it % nblk; transpose_item(W, N, WT, K, 32 * nb, 64 * kb, 32 * nb, scr, lane); }
}
__device__ __forceinline__ void convert_moe(const float* wg, const float* wu, const float* wd, bf16* B1, bf16* B2, LAS float* scr, int gw, int ngw, int lane) {
    constexpr int IPE = 3 * 256;
    for (int it = gw; it < NEXP * IPE; it += ngw) {
        const int e = it / IPE, r = it % IPE, m = r >> 8, q = r & 255;
        if (m < 2) { const int kb = q >> 4, nb = q & 15; const int n0 = 32 * nb;
            const float* W = (m == 0 ? wg : wu) + (size_t)e * D * MOEH;
            const int row_off = (n0 >> 7) * 256 + m * 128 + (n0 & 127);
            transpose_item(W, MOEH, B1 + (size_t)e * D * D, D, row_off, 64 * kb, n0, scr, lane); }
        else { const int kb = q >> 5, nb = q & 31;
            transpose_item(wd + (size_t)e * MOEH * D, D, B2 + (size_t)e * D * MOEH, MOEH, 32 * nb, 64 * kb, 32 * nb, scr, lane); }
    }
}
__device__ __forceinline__ int t5_bucket(int n) {
    if (n < 16) return n;
    int large = 16 + (int)(logf((float)n / 16.0f) / logf(8.0f) * 16.0f);
    return large < 31 ? large : 31;
}

__device__ __forceinline__ void ln_store(f32x4 (&v)[4], const float* g, const float* b, float* orow, bf16* brow, int lane) {
    float s = 0.f;
#pragma unroll
    for (int j = 0; j < 4; ++j) s += (v[j].x + v[j].y) + (v[j].z + v[j].w);
    const float mean = wave_sum(s) * (1.f / D); float s2 = 0.f;
#pragma unroll
    for (int j = 0; j < 4; ++j) { v[j] = v[j] - mean; s2 += (v[j].x * v[j].x + v[j].y * v[j].y) + (v[j].z * v[j].z + v[j].w * v[j].w); }
    const float rstd = 1.f / sqrtf(wave_sum(s2) * (1.f / D) + LN_EPS);
#pragma unroll
    for (int j = 0; j < 4; ++j) { const f32x4 gg = *(const f32x4*)(g + 4 * lane + 256 * j), bb = *(const f32x4*)(b + 4 * lane + 256 * j);
        const f32x4 y = v[j] * rstd * gg + bb;
        *(f32x4*)(orow + 4 * lane + 256 * j) = y;
        if (brow) { u32x2 w; w.x = cvt_pk_bf16(y.x, y.y); w.y = cvt_pk_bf16(y.z, y.w); *(u32x2*)(brow + 4 * lane + 256 * j) = w; } }
}

#ifndef PHASES
#define PHASES 0xFFFF
#endif
#define PH(k) ((PHASES >> (k)) & 1)
struct Params { const float* in[22]; float* out; unsigned char* ws; };
enum { I_X = 0, I_RELB, I_AWIN, I_AWOUT, I_ALAM, I_ASUBG, I_SGWIN, I_SGBIN, I_SGLNG, I_SGLNB, I_SGWS, I_SGBS, I_SGWOUT,
       I_MWG, I_MBG, I_MWR, I_MBR, I_MWGATE, I_MWUP, I_MWDOWN, I_LNG, I_LNB };
typedef const __attribute__((address_space(4))) Params* kparams_t;
#define KP() ({ kparams_t _k = (kparams_t)__builtin_amdgcn_kernarg_segment_ptr(); asm volatile("" : "+s"(_k)); _k; })

__global__ void __launch_bounds__(NTHREADS, 2) mega_fwd(Params p_unused) {
    extern __shared__ __attribute__((aligned(16))) unsigned char lds_raw[];
    lds_u8* lds = (lds_u8*)lds_raw;
    const int G = gridDim.x, bx = blockIdx.x;
#define PHASE_IDS() const int tid = tid_opaque(), lane = tid & 63, wave = __builtin_amdgcn_readfirstlane(tid >> 6); (void)lane; (void)wave; \
    const int gw = vcu * NWAVES + wave, ngw = G * NWAVES, gtid = bx * NTHREADS + tid, ngt = G * NTHREADS; (void)gw; (void)ngw; (void)gtid; (void)ngt
    const int vcu = (G % 8 == 0) ? (bx % 8) * (G / 8) + bx / 8 : bx;
    for (int u = threadIdx.x; u < (LDS_BYTES - LDSCTL_OFF) / 4; u += NTHREADS) ((LAS unsigned*)(lds + LDSCTL_OFF))[u] = 0u;
    __syncthreads();
    XcdBarrier bar;
    { kparams_t kp = KP(); bar = xcd_barrier_post((unsigned*)(kp->ws + WS_CTL) + 4096, (volatile LAS unsigned*)(lds + L_MISC)); }
#define GRID_BAR() xcd_barrier(bar)

    if (PH(0)) {
        PHASE_IDS(); kparams_t kp = KP(); unsigned char* ws = kp->ws;
        LAS float* scr = (LAS float*)(lds + wave * 16384);
        transpose_matrix(kp->in[I_AWIN], D, NQKV, (bf16*)(ws + WS_WQKV), scr, gw, ngw, lane);
        transpose_matrix(kp->in[I_AWOUT], D, D, (bf16*)(ws + WS_WO), scr, gw, ngw, lane);
        transpose_matrix(kp->in[I_SGWIN], D, 2 * SGH, (bf16*)(ws + WS_W1), scr, gw, ngw, lane);
        transpose_matrix(kp->in[I_SGWOUT], SGH, D, (bf16*)(ws + WS_W2), scr, gw, ngw, lane);
        convert_moe(kp->in[I_MWGATE], kp->in[I_MWUP], kp->in[I_MWDOWN], (bf16*)(ws + WS_MOE1), (bf16*)(ws + WS_MOE2), scr, gw, ngw, lane);
        { const float* wgp = kp->in[I_MWG]; const float* wrp = kp->in[I_MWR]; bf16* wr_t = (bf16*)(ws + WS_WR);
          for (int i = gtid; i < 2 * 256 * D; i += ngt) { const int l = i / (256 * D), n = (i / D) % 256, k = i % D;
              float v = 0.f; if (n < 8) v = wgp[(size_t)l * D * 8 + k * 8 + n]; else if (n < 72) v = wrp[(size_t)l * D * 64 + k * 64 + (n - 8)];
              wr_t[i] = (bf16)(cvt_pk_bf16(v, 0.f) & 0xffffu); } }
        { const float* w_s = kp->in[I_SGWS]; bf16* wtril = (bf16*)(ws + WS_WTRIL);
          for (int i = gtid; i < SGG * SGC * SGC; i += ngt) { const int t = (i / SGC) % SGC, s_ = i % SGC; const float v = (s_ <= t) ? w_s[i] : 0.f; wtril[i] = (bf16)(cvt_pk_bf16(v, 0.f) & 0xffffu); } }
        { const float* rel_bias = kp->in[I_RELB]; float* dtab = (float*)(ws + WS_DTAB);
          for (int i = gtid; i < NHEAD * 128; i += ngt) { const int h = i / 128, d = i % 128; dtab[i] = (rel_bias[t5_bucket(d) * NHEAD + h] - rel_bias[31 * NHEAD + h]) * LOG2E; } }
        { const float* x = kp->in[I_X]; bf16* hb = (bf16*)(ws + WS_HB);
          for (size_t i = gtid; i < (size_t)NTOK * D / 8; i += ngt) { const f32x4 a = *(const f32x4*)(x + i * 8), b = *(const f32x4*)(x + i * 8 + 4);
              u32x4 w; w.x = cvt_pk_bf16(a.x, a.y); w.y = cvt_pk_bf16(a.z, a.w); w.z = cvt_pk_bf16(b.x, b.y); w.w = cvt_pk_bf16(b.z, b.w); *(u32x4*)(hb + i * 8) = w; } }
    }
    GRID_BAR();

#pragma unroll 1
    for (int layer = 0; layer < 2; ++layer) {
        if (layer == 0) {
            if (PH(1)) { kparams_t kp = KP(); unsigned char* ws = kp->ws;
              pg8::Gemm g{(const bf16*)(ws + WS_HB), (const bf16*)(ws + WS_WQKV), D, 0}; pg8::StaticOrder S{NTOK / 256, NQKV / 256, G, bx};
              pg8::EpiBf16<0> E{(bf16*)(ws + WS_QKV), NQKV, nullptr, D, (size_t)D, 0.125f * LOG2E};
              pg8::gemm_phase<pg8::EpiBf16<0>, pg8::StaticOrder, true, false>(lds, g, S, E); }
            GRID_BAR();
            if (PH(2)) { PHASE_IDS(); kparams_t kp = KP(); unsigned char* ws = kp->ws;
              float lam;
              { const float* al = kp->in[I_ALAM]; const float a = al[lane] * al[64 + lane], b = al[128 + lane] * al[192 + lane];
                lam = __expf(wave_sum(a)) - __expf(wave_sum(b)) + 0.2f; }
              const int bh = vcu >> 1, half = vcu & 1;
#pragma unroll 1
              for (int i = 0; i < 8; ++i) { const int s_ = 2 * (i >> 1) + half; const int qt = (i & 1) ? 15 - s_ : s_;
                  da::attn_unit(bh >> 3, bh & 7, qt, (const bf16*)(ws + WS_QKV), (bf16*)(ws + WS_OB), (const float*)(ws + WS_DTAB), kp->in[I_ASUBG], lam, lds); } }
            GRID_BAR();
            if (PH(3)) { kparams_t kp = KP(); unsigned char* ws = kp->ws;
              pg8::Gemm g{(const bf16*)(ws + WS_OB), (const bf16*)(ws + WS_WO), D, 0}; pg8::StaticOrder S{NTOK / 256, D / 256, G, bx};
              pg8::EpiResF32 E{kp->in[I_X], kp->out, D, DN_ALPHA};
              pg8::gemm_phase<pg8::EpiResF32, pg8::StaticOrder, true, false>(lds, g, S, E); }
            GRID_BAR();
        } else {
            if (PH(4)) { kparams_t kp = KP(); unsigned char* ws = kp->ws;
              pg8::Gemm g{(const bf16*)(ws + WS_HB), (const bf16*)(ws + WS_W1), D, 0}; pg8::StaticOrder S{NTOK / 256, 2 * SGH / 256, G, bx};
              pg8::EpiBf16<1> E{(bf16*)(ws + WS_U), SGH, kp->in[I_SGBIN], SGH, (size_t)(WS_V - WS_U) / 2, 1.f};
              pg8::gemm_phase<pg8::EpiBf16<1>, pg8::StaticOrder, true, false>(lds, g, S, E); }
            GRID_BAR();
            if (PH(5)) { kparams_t kp = KP(); unsigned char* ws = kp->ws;
#pragma unroll 1
              for (int ch = bx; ch < NTOK / SGC; ch += G)
                  sg::chunk_unit(ch, (bf16*)(ws + WS_U), (const bf16*)(ws + WS_V), kp->in[I_SGLNG], kp->in[I_SGLNB], (const bf16*)(ws + WS_WTRIL), kp->in[I_SGBS], lds); }
            GRID_BAR();
            if (PH(6)) { PHASE_IDS(); kparams_t kp = KP(); unsigned char* ws = kp->ws;
              LAS float* scr = (LAS float*)(lds + wave * 16384);
              convert_moe(kp->in[I_MWGATE] + (size_t)NEXP * D * MOEH, kp->in[I_MWUP] + (size_t)NEXP * D * MOEH, kp->in[I_MWDOWN] + (size_t)NEXP * MOEH * D,
                          (bf16*)(ws + WS_MOE1), (bf16*)(ws + WS_MOE2), scr, gw, ngw, lane);
              __syncthreads(); }
            if (PH(6)) { kparams_t kp = KP(); unsigned char* ws = kp->ws;
              pg8::Gemm g{(const bf16*)(ws + WS_U), (const bf16*)(ws + WS_W2), SGH, 0}; pg8::StaticOrder S{NTOK / 256, D / 256, G, bx};
              pg8::EpiResF32 E{kp->out, kp->out, D, DN_ALPHA};
              pg8::gemm_phase<pg8::EpiResF32, pg8::StaticOrder, true, false>(lds, g, S, E); }
            GRID_BAR();
        }
        if (PH(7)) {
            PHASE_IDS();
            { kparams_t kp = KP(); unsigned char* ws = kp->ws; float* out = kp->out; bf16* hb = (bf16*)(ws + WS_HB);
              const float* g1 = kp->in[I_LNG] + (size_t)(layer * 2 + 0) * D; const float* b1 = kp->in[I_LNB] + (size_t)(layer * 2 + 0) * D;
#pragma unroll 1
              for (int i = 0; i < 32; ++i) { const size_t row = (size_t)bx * 256 + wave * 32 + i; float* orow = out + row * D; f32x4 v[4];
#pragma unroll
                  for (int j = 0; j < 4; ++j) v[j] = *(const f32x4*)(orow + 4 * lane + 256 * j);
                  ln_store(v, g1, b1, orow, hb + row * D, lane); }
              VM_WAIT(); __builtin_amdgcn_fence(__ATOMIC_ACQUIRE, "agent"); VM_WAIT(); __syncthreads(); }
            { kparams_t kp = KP(); unsigned char* ws = kp->ws;
              pg8::Gemm g{(const bf16*)(ws + WS_HB), (const bf16*)(ws + WS_WR) + (size_t)layer * 256 * D, D, 0}; pg8::SingleOrder S{bx};
              pg8::EpiRouter E{kp->in[I_MBG] + layer * 8, kp->in[I_MBR] + layer * 64};
              pg8::gemm_phase<pg8::EpiRouter, pg8::SingleOrder, false, false>(lds, g, S, E); }
            LAS int* wcnt = (LAS int*)(lds + L_WCNT);
            if (tid < 64) wcnt[tid] = 0;
            __syncthreads();
            if (tid < 256) { kparams_t kp = KP(); unsigned char* ws = kp->ws; int* aexp = (int*)(ws + WS_AEXP); float* agate = (float*)(ws + WS_AGATE);
                const LAS float* lg = (const LAS float*)lds + tid * 73;
                float gmax = lg[0]; int gi = 0;
#pragma unroll
                for (int j = 1; j < 8; ++j) { const float v = lg[j]; if (v > gmax) { gmax = v; gi = j; } }
                float gs = 0.f;
#pragma unroll
                for (int j = 0; j < 8; ++j) gs += __expf(lg[j] - gmax);
                const float ggate = 1.0f / gs;
                const LAS float* el = lg + 8 + gi * 8;
                float v1 = el[0]; int i1 = 0;
#pragma unroll
                for (int j = 1; j < 8; ++j) { const float v = el[j]; if (v > v1) { v1 = v; i1 = j; } }
                float v2 = -INFINITY; int i2 = 0;
#pragma unroll
                for (int j = 0; j < 8; ++j) { const float v = el[j]; if (j != i1 && v > v2) { v2 = v; i2 = j; } }
                const float e2 = __expf(v2 - v1), p1 = 1.0f / (1.0f + e2), p2 = e2 * p1;
                const int tok = bx * 256 + tid; const int e1x = gi * 8 + i1, e2x = gi * 8 + i2;
                aexp[2 * tok] = e1x; aexp[2 * tok + 1] = e2x; agate[2 * tok] = ggate * p1; agate[2 * tok + 1] = ggate * p2;
                atomicAdd((int*)&wcnt[e1x], 1); atomicAdd((int*)&wcnt[e2x], 1); }
            __syncthreads();
            if (tid < 64) { kparams_t kp = KP(); int* hist = (int*)(kp->ws + WS_HIST); hist[bx * 64 + tid] = wcnt[tid]; }
        }
        GRID_BAR();
        LAS int* pstL = (LAS int*)(lds + L_PST);
        if (PH(8)) {
            PHASE_IDS(); kparams_t kp = KP(); unsigned char* ws = kp->ws; const int* hist = (const int*)(ws + WS_HIST); const int* aexp = (const int*)(ws + WS_AEXP); unsigned* srt = (unsigned*)(ws + WS_SRT);
            LAS int* cntL = (LAS int*)(lds + L_CNT);
            LAS int* offsL = (LAS int*)(lds + L_OFFS); LAS int* wcnt = (LAS int*)(lds + L_WCNT); LAS int* part = (LAS int*)(lds + L_PART);
            { const int e = tid & 63, pt = tid >> 6; int sa = 0, sb = 0;
              for (int w = pt * 32; w < pt * 32 + 32; ++w) { const int hv = hist[w * 64 + e]; sa += hv; if (w < bx) sb += hv; }
              part[pt * 64 + e] = sa; part[512 + pt * 64 + e] = sb; }
            __syncthreads();
            if (tid < 64) { int sa = 0, sb = 0;
#pragma unroll
                for (int pt = 0; pt < 8; ++pt) { sa += part[pt * 64 + tid]; sb += part[512 + pt * 64 + tid]; }
                cntL[tid] = sa; offsL[tid] = sb; wcnt[tid] = 0; }
            __syncthreads();
            if (tid == 0) { int acc = 0; for (int e = 0; e < 64; ++e) { pstL[e] = acc; acc += (cntL[e] + 255) & ~255; } pstL[64] = acc; pstL[65] = acc; pstL[66] = acc; pstL[67] = acc; }
            __syncthreads();
            if (tid < 256) { const int tok = bx * 256 + tid;
#pragma unroll
                for (int k = 0; k < 2; ++k) { const int a = 2 * tok + k; const int e = aexp[a]; const int rank = atomicAdd((int*)&wcnt[e], 1);
                    srt[pstL[e] + offsL[e] + rank] = (unsigned)a; } }
            if (bx < 64) { const int e = bx; const int c = cntL[e], cp = (c + 255) & ~255; for (int i = c + tid; i < cp; i += NTHREADS) srt[pstL[e] + i] = SRT_MARK; }
        }
        GRID_BAR();
        if (PH(9)) { kparams_t kp = KP(); unsigned char* ws = kp->ws; const int ntile = pstL[64] >> 8;
          pg8::Gemm g{(const bf16*)(ws + WS_HB), (const bf16*)(ws + WS_MOE1), D, (size_t)D * D * 2}; pg8::MoeOrder S{ntile, G, bx, pstL, (const unsigned*)(ws + WS_SRT), true};
          pg8::EpiSwiglu E{(bf16*)(ws + WS_HM)};
          pg8::gemm_phase<pg8::EpiSwiglu, pg8::MoeOrder, true, true>(lds, g, S, E); }
        GRID_BAR();
        if (PH(10)) { kparams_t kp = KP(); unsigned char* ws = kp->ws; const int ntile = pstL[64] >> 8;
          pg8::Gemm g{(const bf16*)(ws + WS_HM), (const bf16*)(ws + WS_MOE2), MOEH, (size_t)D * MOEH * 2}; pg8::MoeOrder S{ntile, G, bx, pstL, (const unsigned*)(ws + WS_SRT), false};
          pg8::EpiScatter E{(bf16*)(ws + WS_YSLOT), (const unsigned*)(ws + WS_SRT), (const float*)(ws + WS_AGATE)};
          pg8::gemm_phase<pg8::EpiScatter, pg8::MoeOrder, true, false>(lds, g, S, E); }
        GRID_BAR();
        if (PH(11)) {
            PHASE_IDS(); kparams_t kp = KP(); unsigned char* ws = kp->ws; float* out = kp->out; bf16* hb = (bf16*)(ws + WS_HB); const bf16* yslot = (const bf16*)(ws + WS_YSLOT);
            const float* g2 = kp->in[I_LNG] + (size_t)(layer * 2 + 1) * D; const float* b2 = kp->in[I_LNB] + (size_t)(layer * 2 + 1) * D;
#pragma unroll 1
            for (int i = 0; i < 32; ++i) { const size_t row = (size_t)bx * 256 + wave * 32 + i; float* orow = out + row * D; f32x4 v[4];
                const bf16* y0 = yslot + (2 * row) * D, * y1 = y0 + D;
#pragma unroll
                for (int j = 0; j < 4; ++j) { const f32x4 h = *(const f32x4*)(orow + 4 * lane + 256 * j); const u32x2 a = *(const u32x2*)(y0 + 4 * lane + 256 * j), b = *(const u32x2*)(y1 + 4 * lane + 256 * j);
                    v[j].x = h.x * DN_ALPHA + (bf_lo(a.x) + bf_lo(b.x)); v[j].y = h.y * DN_ALPHA + (bf_hi(a.x) + bf_hi(b.x));
                    v[j].z = h.z * DN_ALPHA + (bf_lo(a.y) + bf_lo(b.y)); v[j].w = h.w * DN_ALPHA + (bf_hi(a.y) + bf_hi(b.y)); }
                ln_store(v, g2, b2, orow, layer == 0 ? hb + row * D : (bf16*)nullptr, lane); }
        }
        if (layer == 0) GRID_BAR();
    }
}

extern "C" void kernel_launch(void* const* d_in, const int* in_sizes, int n_in, void* d_out, int out_size, void* d_ws, size_t ws_size, hipStream_t stream) {
    static int ok = 0;
    if (ok == 0) {
        if (n_in != 22 || in_sizes[0] != NTOK * D || out_size != NTOK * D || ws_size < WS_END) {
            fprintf(stderr, "kernel_launch: shape mismatch: n_in %d in0 %d out %d ws %zu (need %zu)\n", n_in, n_in > 0 ? in_sizes[0] : -1, out_size, ws_size, (size_t)WS_END); ok = -1; return; }
        if (hipFuncSetAttribute((const void*)mega_fwd, hipFuncAttributeMaxDynamicSharedMemorySize, LDS_BYTES) != hipSuccess) { fprintf(stderr, "kernel_launch: hipFuncSetAttribute failed\n"); ok = -1; return; }
        int per_cu = 0;
        if (hipOccupancyMaxActiveBlocksPerMultiprocessor(&per_cu, (const void*)mega_fwd, NTHREADS, LDS_BYTES) != hipSuccess || per_cu < 1)
            fprintf(stderr, "kernel_launch: occupancy query reports %d workgroups per CU\n", per_cu);
        (void)hipGetLastError();
        ok = 1;
    }
    if (ok < 0) return;
    if (hipMemsetAsync((char*)d_ws + WS_CTL, 0, CTL_ZERO_BYTES, stream) != hipSuccess) { fprintf(stderr, "kernel_launch: memset failed\n"); return; }
    Params p{};
    for (int i = 0; i < 22; ++i) p.in[i] = (const float*)d_in[i];
    p.out = (float*)d_out; p.ws = (unsigned char*)d_ws;
    hipLaunchKernelGGL(mega_fwd, dim3(GRID), dim3(NTHREADS), LDS_BYTES, stream, p);
    const hipError_t le = hipPeekAtLastError();
    if (le != hipSuccess) fprintf(stderr, "kernel_launch: launch failed: %s\n", hipGetErrorName(le));
}
```

```cpp
#include <hip/hip_runtime.h>
#include <hip/hip_bf16.h>
#include <cstdio>
#include <cstdint>

#define LAS __attribute__((address_space(3)))
#define GAS __attribute__((address_space(1)))
typedef unsigned short bf16;
typedef short bf16x8 __attribute__((ext_vector_type(8)));
typedef short s16x4 __attribute__((ext_vector_type(4)));
typedef float f32x4 __attribute__((ext_vector_type(4)));
typedef float f32x2 __attribute__((ext_vector_type(2)));
typedef float f32x16 __attribute__((ext_vector_type(16)));
typedef unsigned u32x4 __attribute__((ext_vector_type(4)));
typedef unsigned u32x2 __attribute__((ext_vector_type(2)));
typedef LAS unsigned char lds_u8;

constexpr int D = 1024, BATCH = 16, SEQ = 4096, NTOK = BATCH * SEQ;
constexpr int NQKV = 3072, NHEAD = 8;
constexpr int SGH = 3072, SGG = 8, SGC = 128, SGGD = 384;
constexpr int NEXP = 64, MOEH = 512, NASG = NTOK * 2;
constexpr int PMAX = NASG + NEXP * 256;
constexpr float LN_EPS = 1e-5f, DN_ALPHA = 1.4142135623730951f;
constexpr float LOG2E = 1.4426950408889634f;
constexpr unsigned SRT_MARK = 0xFFFFFFFFu;
constexpr int NWAVES = 8, NTHREADS = 512, GRID = 256;

constexpr size_t MiB = 1u << 20;
constexpr size_t WS_CTL = 0, CTL_ZERO_BYTES = 1 * MiB;
constexpr size_t WS_DTAB = 1 * MiB;
constexpr size_t WS_WTRIL = 1 * MiB + 65536;
constexpr size_t WS_WR = 2 * MiB;
constexpr size_t WS_HIST = 3 * MiB;
constexpr size_t WS_AEXP = 4 * MiB;
constexpr size_t WS_AGATE = 5 * MiB;
constexpr size_t WS_SRT = 6 * MiB;
constexpr size_t WS_WQKV = 8 * MiB;
constexpr size_t WS_WO = 14 * MiB;
constexpr size_t WS_W1 = 16 * MiB;
constexpr size_t WS_W2 = 28 * MiB;
constexpr size_t WS_HB = 34 * MiB;
constexpr size_t WS_ARENA = 162 * MiB;
constexpr size_t WS_QKV = WS_ARENA;
constexpr size_t WS_OB = WS_ARENA + 384 * MiB;
constexpr size_t WS_YSLOT = WS_ARENA;
constexpr size_t WS_HM = WS_ARENA + 256 * MiB;
constexpr size_t WS_U = WS_ARENA;
constexpr size_t WS_V = WS_ARENA + 384 * MiB;
constexpr size_t WS_MOE1 = WS_ARENA + 576 * MiB;
constexpr size_t WS_MOE2 = WS_MOE1 + 128 * MiB;
constexpr size_t WS_END = WS_MOE2 + 64 * MiB;
static_assert(WS_HM + (size_t)PMAX * MOEH * 2 <= WS_MOE1, "ws map");
static_assert(WS_V + (size_t)NTOK * SGH * 2 <= WS_END, "ws map");

constexpr int RING_BYTES = 131072;
constexpr int LDSCTL_OFF = RING_BYTES;
constexpr int L_MISC = LDSCTL_OFF;
constexpr int L_CNT = LDSCTL_OFF + 64;
constexpr int L_PST = L_CNT + 256;
constexpr int L_OFFS = L_PST + 272;
constexpr int L_WCNT = L_OFFS + 256;
constexpr int L_PART = L_WCNT + 256;
constexpr int L_END = L_PART + 4096;
constexpr int LDS_BYTES = 147456;
static_assert(L_END <= LDS_BYTES, "LDS map");

__device__ __forceinline__ unsigned cvt_pk_bf16(float lo, float hi) { unsigned r; asm volatile("v_cvt_pk_bf16_f32 %0, %1, %2" : "=v"(r) : "v"(lo), "v"(hi)); return r; }
__device__ __forceinline__ float bf_lo(unsigned w) { return __uint_as_float(w << 16); }
__device__ __forceinline__ float bf_hi(unsigned w) { return __uint_as_float(w & 0xffff0000u); }
__device__ __forceinline__ float wave_sum(float v) {
#pragma unroll
    for (int o = 1; o < 64; o <<= 1) v += __shfl_xor(v, o);
    return v;
}
__device__ __forceinline__ float gelu_tanh(float x) {
    const float inner = x * (1.0f + 0.044715f * x * x);
    const float e = __builtin_amdgcn_exp2f(-2.302208198f * inner);
    return x * __builtin_amdgcn_rcpf(1.0f + e);
}
__device__ __forceinline__ float silu_f(float x) { return x * __builtin_amdgcn_rcpf(1.0f + __builtin_amdgcn_exp2f(-LOG2E * x)); }
__device__ __forceinline__ int tid_opaque() { int t = threadIdx.x; asm volatile("" : "+v"(t)); return t; }
#define LDS_WAIT() asm volatile("s_waitcnt lgkmcnt(0)" ::: "memory")
#define VM_WAIT() asm volatile("s_waitcnt vmcnt(0)" ::: "memory")

namespace pg8 {
constexpr int BM = 256, BK = 64, HALF = 128, HTB = HALF * BK * 2, STAGE_BYTES = 8 * HTB, NXCD = 8, WGM = 8;
__device__ __forceinline__ int lds_byte(int r, int c) { const int st = (r >> 4) * 2 + (c >> 5), rr = r & 15, cc = c & 31, ob = rr * 64 + cc * 2; return st * 1024 + (ob ^ (((ob >> 9) & 1) << 5)); }
__device__ __forceinline__ void stage_rc(int b, int& R, int& C) { const int st = b / 1024, sb = b % 1024, swz = sb ^ (((sb >> 9) & 1) << 5); R = (st >> 1) * 16 + swz / 64; C = (st & 1) * 32 + (swz % 64) / 2; }
__device__ __forceinline__ int perm32(int rho) { const int n = rho >> 4, i = rho & 15; return 8 * (i >> 2) + 4 * n + (i & 3); }

struct Unit { int pm, pn, e; };
struct Gemm { const bf16* A; const bf16* Bt; int K; size_t bstride; };

__device__ __forceinline__ bool static_tile(int i, int G, int c, int nM, int nN, int& pm, int& pn) {
    const int nwg = nM * nN; const long L = (long)i * G + c; if (L >= nwg) return false;
    int wgid = (int)L; { const int q = nwg / NXCD, r = nwg % NXCD, xcd = wgid % NXCD, off = wgid / NXCD; wgid = (xcd < r ? xcd * (q + 1) : r * (q + 1) + (xcd - r) * q) + off; }
    const int nig = WGM * nN, gid = wgid / nig, fm = gid * WGM, gsz = (nM - fm) < WGM ? (nM - fm) : WGM;
    pm = fm + ((wgid % nig) % gsz); pn = (wgid % nig) / gsz; return true;
}
struct StaticOrder {
    int nM, nN, G, c;
    __device__ __forceinline__ bool next(int i, Unit& u) const { u.e = 0; return static_tile(i, G, c, nM, nN, u.pm, u.pn); }
    __device__ __forceinline__ unsigned arow(const Unit& u, int r) const { return (unsigned)(u.pm * BM + r); }
};
struct SingleOrder {
    int pm;
    __device__ __forceinline__ bool next(int i, Unit& u) const { u.e = 0; u.pm = pm; u.pn = 0; return i == 0; }
    __device__ __forceinline__ unsigned arow(const Unit& u, int r) const { return (unsigned)(u.pm * BM + r); }
};
struct MoeOrder {
    int nM, G, c; const LAS int* pst; const unsigned* srt; bool gather;
    __device__ __forceinline__ bool next(int i, Unit& u) const {
        if (!static_tile(i, G, c, nM, 4, u.pm, u.pn)) return false;
        const int x = u.pm * BM, lane = tid_opaque() & 63;
        const int lo = pst[lane], hi = pst[lane + 1];
        const unsigned long long m = __ballot(lo <= x && x < hi);
        u.e = __builtin_amdgcn_readfirstlane(m ? __builtin_ctzll(m) : 0);
        return true;
    }
    __device__ __forceinline__ unsigned arow(const Unit& u, int r) const {
        if (!gather) return (unsigned)(u.pm * BM + r);
        const unsigned a = srt[u.pm * BM + r]; return a == SRT_MARK ? 0u : (a >> 1);
    }
};

template <int ACT> struct EpiBf16 {
    static constexpr bool PERM = true, AFTER_DRAIN = false;
    bf16* O; int ldc; const float* bias; int split_cols; size_t split_stride; float scale0; int nostore;
    __device__ __forceinline__ void operator()(const f32x4 (&acc)[2][2][4][2], const Unit& u, int wr, int wc, int fr, int fq) const {
        const int row0 = u.pm * BM + wr * 64 + fr; int colt = u.pn * BM; bf16* base = O;
        float sc = 1.f; if (split_cols) { const int t = colt / split_cols; base += (size_t)t * split_stride; colt -= t * split_cols; if (t == 0) sc = scale0; }
        const int col0 = colt + wc * 32 + 8 * fq, bcol0 = u.pn * BM + wc * 32 + 8 * fq;
        f32x4 bv[2][2];
#pragma unroll
        for (int bj = 0; bj < 2; ++bj)
#pragma unroll
            for (int n = 0; n < 2; ++n) bv[bj][n] = bias ? *(const f32x4*)(bias + bcol0 + bj * HALF + 4 * n) : (f32x4){0.f, 0.f, 0.f, 0.f};
#pragma unroll
        for (int ai = 0; ai < 2; ++ai)
#pragma unroll
            for (int m = 0; m < 4; ++m) { bf16* rowp = base + (size_t)(row0 + ai * HALF + m * 16) * ldc + col0;
#pragma unroll
                for (int bj = 0; bj < 2; ++bj) { f32x4 v0 = acc[ai][bj][m][0] + bv[bj][0], v1 = acc[ai][bj][m][1] + bv[bj][1];
                    if (ACT == 1) {
#pragma unroll
                        for (int j = 0; j < 4; ++j) { v0[j] = gelu_tanh(v0[j]); v1[j] = gelu_tanh(v1[j]); } }
                    v0 = v0 * sc; v1 = v1 * sc; u32x4 w; w.x = cvt_pk_bf16(v0[0], v0[1]); w.y = cvt_pk_bf16(v0[2], v0[3]); w.z = cvt_pk_bf16(v1[0], v1[1]); w.w = cvt_pk_bf16(v1[2], v1[3]);
                    if (!nostore) *(u32x4*)(rowp + bj * HALF) = w; } }
    }
};
struct EpiNull {
    static constexpr bool PERM = true, AFTER_DRAIN = false; f32x4* O;
    __device__ __forceinline__ void operator()(const f32x4 (&acc)[2][2][4][2], const Unit& u, int wr, int wc, int fr, int fq) const {
#pragma unroll
        for (int ai = 0; ai < 2; ++ai)
#pragma unroll
            for (int bj = 0; bj < 2; ++bj)
#pragma unroll
                for (int m = 0; m < 4; ++m)
#pragma unroll
                    for (int n = 0; n < 2; ++n) if (u.pm == 0x7fffffff) O[(((ai * 2 + bj) * 4 + m) * 2 + n) * 4096 + fr * 64 + fq * 16 + wc * 4 + wr] = acc[ai][bj][m][n];
    }
};
struct EpiResF32 {
    static constexpr bool PERM = false, AFTER_DRAIN = false;
    const float* res; float* out; int ldc; float alpha;
    __device__ __forceinline__ void operator()(const f32x4 (&acc)[2][2][4][2], const Unit& u, int wr, int wc, int fr, int fq) const {
        const int col0 = u.pn * BM + wc * 32 + 4 * fq;
#pragma unroll
        for (int ai = 0; ai < 2; ++ai)
#pragma unroll
            for (int m = 0; m < 4; ++m) { const size_t off = (size_t)(u.pm * BM + ai * HALF + wr * 64 + m * 16 + fr) * ldc + col0;
#pragma unroll
                for (int bj = 0; bj < 2; ++bj)
#pragma unroll
                    for (int n = 0; n < 2; ++n) { const f32x4 r = *(const f32x4*)(res + off + bj * HALF + n * 16); *(f32x4*)(out + off + bj * HALF + n * 16) = r * alpha + acc[ai][bj][m][n]; } }
    }
};
struct EpiResBf16 {
    static constexpr bool PERM = true, AFTER_DRAIN = false;
    const bf16* res; bf16* out; int ldc; float alpha;
    __device__ __forceinline__ void operator()(const f32x4 (&acc)[2][2][4][2], const Unit& u, int wr, int wc, int fr, int fq) const {
        const int col0 = u.pn * BM + wc * 32 + 8 * fq;
#pragma unroll
        for (int ai = 0; ai < 2; ++ai)
#pragma unroll
            for (int m = 0; m < 4; ++m) { const size_t off = (size_t)(u.pm * BM + ai * HALF + wr * 64 + m * 16 + fr) * ldc + col0;
#pragma unroll
                for (int bj = 0; bj < 2; ++bj) { const u32x4 r = *(const u32x4*)(res + off + bj * HALF);
                    const f32x4 a0 = acc[ai][bj][m][0], a1 = acc[ai][bj][m][1]; u32x4 w;
                    w.x = cvt_pk_bf16(bf_lo(r.x) * alpha + a0[0], bf_hi(r.x) * alpha + a0[1]); w.y = cvt_pk_bf16(bf_lo(r.y) * alpha + a0[2], bf_hi(r.y) * alpha + a0[3]);
                    w.z = cvt_pk_bf16(bf_lo(r.z) * alpha + a1[0], bf_hi(r.z) * alpha + a1[1]); w.w = cvt_pk_bf16(bf_lo(r.w) * alpha + a1[2], bf_hi(r.w) * alpha + a1[3]);
                    *(u32x4*)(out + off + bj * HALF) = w; } }
    }
};
struct EpiRouter {
    static constexpr bool PERM = false, AFTER_DRAIN = true;
    const float* bg; const float* br;
    __device__ __forceinline__ void fused(f32x4 (&acc)[2][2][4][2], const Unit& u, int wr, int wc, int fr, int fq, lds_u8* lds, int wid, int lane) const {
        LAS float* L = (LAS float*)lds;
        if (wc < 3) {
#pragma unroll
            for (int n = 0; n < 2; ++n) { const int c0 = wc * 32 + 16 * n + 4 * fq;
#pragma unroll
                for (int j = 0; j < 4; ++j) { const int c = c0 + j; if (c < 72) { const float b = c < 8 ? bg[c] : br[c - 8];
#pragma unroll
                    for (int ai = 0; ai < 2; ++ai)
#pragma unroll
                        for (int m = 0; m < 4; ++m) L[(ai * HALF + wr * 64 + m * 16 + fr) * 73 + c] = acc[ai][0][m][n][j] + b; } } } }
    }
};
struct EpiSwiglu {
    static constexpr bool PERM = true, AFTER_DRAIN = false;
    bf16* O;
    __device__ __forceinline__ void operator()(const f32x4 (&acc)[2][2][4][2], const Unit& u, int wr, int wc, int fr, int fq) const {
        const int col0 = u.pn * 128 + wc * 32 + 8 * fq;
#pragma unroll
        for (int ai = 0; ai < 2; ++ai)
#pragma unroll
            for (int m = 0; m < 4; ++m) { bf16* rowp = O + (size_t)(u.pm * BM + ai * HALF + wr * 64 + m * 16 + fr) * MOEH + col0;
                float o[8];
#pragma unroll
                for (int n = 0; n < 2; ++n)
#pragma unroll
                    for (int j = 0; j < 4; ++j) o[4 * n + j] = silu_f(acc[ai][0][m][n][j]) * acc[ai][1][m][n][j];
                u32x4 w; w.x = cvt_pk_bf16(o[0], o[1]); w.y = cvt_pk_bf16(o[2], o[3]); w.z = cvt_pk_bf16(o[4], o[5]); w.w = cvt_pk_bf16(o[6], o[7]);
                *(u32x4*)rowp = w; }
    }
};
struct EpiScatter {
    static constexpr bool PERM = true, AFTER_DRAIN = false;
    bf16* Y; const unsigned* srt; const float* gate;
    __device__ __forceinline__ void operator()(const f32x4 (&acc)[2][2][4][2], const Unit& u, int wr, int wc, int fr, int fq) const {
        const int col0 = u.pn * BM + wc * 32 + 8 * fq;
#pragma unroll
        for (int ai = 0; ai < 2; ++ai)
#pragma unroll
            for (int m = 0; m < 4; ++m) { const unsigned a = srt[u.pm * BM + ai * HALF + wr * 64 + m * 16 + fr];
                if (a != SRT_MARK) { const float gt = gate[a]; bf16* rowp = Y + (size_t)a * D + col0;
#pragma unroll
                    for (int bj = 0; bj < 2; ++bj) { const f32x4 v0 = acc[ai][bj][m][0] * gt, v1 = acc[ai][bj][m][1] * gt;
                        u32x4 w; w.x = cvt_pk_bf16(v0[0], v0[1]); w.y = cvt_pk_bf16(v0[2], v0[3]); w.z = cvt_pk_bf16(v1[0], v1[1]); w.w = cvt_pk_bf16(v1[2], v1[3]);
                        *(u32x4*)(rowp + bj * HALF) = w; } } }
    }
};

template <class Epi, class Sched, bool ALIGN_EPI, bool GATHER>
__device__ __forceinline__ void gemm_phase(lds_u8* lds, const Gemm g, const Sched& S, const Epi& E) {
    const int tid = tid_opaque(), wid = __builtin_amdgcn_readfirstlane(tid >> 6), lane = tid & 63, wr = wid >> 2, wc = wid & 3, fr = lane & 15, fq = lane >> 4;
    const int K = g.K, nt = K / BK;
    unsigned voffB[2], voffA[2]; int Rl[2], Cl[2];
#pragma unroll
    for (int i = 0; i < 2; ++i) { int R, C; stage_rc(tid * 16 + i * 8192, R, C); const int Rb = Epi::PERM ? ((R & ~31) + perm32(R & 31)) : R;
        Rl[i] = R; Cl[i] = C; voffA[i] = (unsigned)(R * K + C) * 2u; voffB[i] = (unsigned)(Rb * K + C) * 2u; }
    const size_t kstep = (size_t)(BK * 2);
    const size_t hstep = (size_t)HALF * K * 2;
    const size_t tstep = 2 * hstep;
    const unsigned ldsw = (unsigned)wid * 1024u;
    const int aoff = lds_byte(wr * 64 + fr, fq * 8), boff = lds_byte(wc * 32 + fr, fq * 8);
    const char* const Ab = (const char*)g.A;
#define PG8_SA(b, h) (((b) * 2 + (h)) * HTB)
#define PG8_SB(b, h) ((4 + (b) * 2 + (h)) * HTB)
#define PG8_STAGE_B(bufoff, gbase) do { _Pragma("unroll") for (int _i = 0; _i < 2; ++_i) \
        __builtin_amdgcn_global_load_lds((const unsigned*)((const char*)(gbase) + voffB[_i]), (LAS unsigned*)(lds + (bufoff) + ldsw + _i * 8192), 16, 0, 0); } while (0)
#define PG8_STAGE_A(bufoff, kb, ub, vo, h) do { _Pragma("unroll") for (int _i = 0; _i < 2; ++_i) { \
        const char* _src = GATHER ? (Ab + (kb) + (vo)[h][_i]) : ((ub) + (kb) + (size_t)(h) * hstep + voffA[_i]); \
        __builtin_amdgcn_global_load_lds((const unsigned*)_src, (LAS unsigned*)(lds + (bufoff) + ldsw + _i * 8192), 16, 0, 0); } } while (0)
#define PG8_LDA(dst, b, h) do { _Pragma("unroll") for (int m = 0; m < 4; ++m) _Pragma("unroll") for (int k = 0; k < 2; ++k) dst[m][k] = *(const LAS bf16x8*)(lds + PG8_SA(b, h) + aoff + m * 2048 + k * 1024); } while (0)
#define PG8_LDB(dst, b, h) do { _Pragma("unroll") for (int n = 0; n < 2; ++n) _Pragma("unroll") for (int k = 0; k < 2; ++k) dst[n][k] = *(const LAS bf16x8*)(lds + PG8_SB(b, h) + boff + n * 2048 + k * 1024); } while (0)
#define PG8_MMA(ai, bj, At, Bt) do { __builtin_amdgcn_s_setprio(1); _Pragma("unroll") for (int m = 0; m < 4; ++m) _Pragma("unroll") for (int n = 0; n < 2; ++n) _Pragma("unroll") for (int k = 0; k < 2; ++k) \
        acc[ai][bj][m][n] = __builtin_amdgcn_mfma_f32_16x16x32_bf16(Bt[n][k], At[m][k], acc[ai][bj][m][n], 0, 0, 0); __builtin_amdgcn_s_setprio(0); } while (0)
#define PG8_WAIT_V(n) asm volatile("s_waitcnt vmcnt(" #n ")" ::: "memory")
#define PG8_WAIT_L(n) asm volatile("s_waitcnt lgkmcnt(" #n ")" ::: "memory")
#define PG8_BAR __builtin_amdgcn_s_barrier()
#define PG8_SCHED __builtin_amdgcn_sched_barrier(0)
#define PG8_SETVO(vo, u) do { if constexpr (GATHER) { _Pragma("unroll") for (int _h = 0; _h < 2; ++_h) _Pragma("unroll") for (int _i = 0; _i < 2; ++_i) \
        (vo)[_h][_i] = (S.arow((u), _h * HALF + Rl[_i]) * (unsigned)K + (unsigned)Cl[_i]) * 2u; \
        asm volatile("" : "+v"((vo)[0][0]), "+v"((vo)[0][1]), "+v"((vo)[1][0]), "+v"((vo)[1][1])); } } while (0)
    Unit cur, nxt; int ui = 0;
    if (!S.next(0, cur)) return;
    unsigned voC[2][2], voN[2][2];
#pragma unroll
    for (int h = 0; h < 2; ++h)
#pragma unroll
        for (int i = 0; i < 2; ++i) { voC[h][i] = 0u; voN[h][i] = 0u; }
    PG8_SETVO(voC, cur);
    const char* cA = GATHER ? Ab : Ab + (size_t)cur.pm * tstep;
    f32x4 acc[2][2][4][2];
#pragma unroll
    for (int a = 0; a < 2; ++a)
#pragma unroll
        for (int b = 0; b < 2; ++b)
#pragma unroll
            for (int m = 0; m < 4; ++m)
#pragma unroll
                for (int n = 0; n < 2; ++n) acc[a][b][m][n] = (f32x4){0.f, 0.f, 0.f, 0.f};
    bf16x8 At[4][2], B0[2][2], B1[2][2];
    const char* cB = (const char*)g.Bt + (size_t)cur.e * g.bstride + (size_t)cur.pn * tstep;
    PG8_STAGE_B(PG8_SB(0, 0), cB); PG8_STAGE_B(PG8_SB(0, 1), cB + hstep); PG8_STAGE_A(PG8_SA(0, 0), 0, cA, voC, 0); PG8_STAGE_A(PG8_SA(0, 1), 0, cA, voC, 1);
    if (wr == 1) PG8_BAR;
    PG8_WAIT_V(2); PG8_BAR;
    PG8_STAGE_B(PG8_SB(1, 0), cB + kstep); PG8_STAGE_A(PG8_SA(1, 0), kstep, cA, voC, 0); PG8_STAGE_B(PG8_SB(1, 1), cB + hstep + kstep);
    PG8_WAIT_V(6); PG8_BAR;
    for (;;) {
        const bool has_next = S.next(ui + 1, nxt);
        if (has_next) { PG8_SETVO(voN, nxt); }
        else {
#pragma unroll
            for (int h = 0; h < 2; ++h)
#pragma unroll
                for (int i = 0; i < 2; ++i) voN[h][i] = voC[h][i]; }
        const char* nB = has_next ? (const char*)g.Bt + (size_t)nxt.e * g.bstride + (size_t)nxt.pn * tstep : cB;
        const char* nA = (has_next && !GATHER) ? Ab + (size_t)nxt.pm * tstep : cA;
        for (int t = 0; t < nt; t += 2) {
            const bool last = (t == nt - 2);
            const size_t k1 = (size_t)(t + 1) * kstep;
            const size_t k2 = last ? 0 : (size_t)(t + 2) * kstep, k3 = k2 + kstep; const char* u2 = last ? nA : cA;
            const char* b2 = last ? nB : cB + (size_t)(t + 2) * kstep;
            const char* b3 = b2 + kstep;
            unsigned vo2[2][2];
#pragma unroll
            for (int h = 0; h < 2; ++h)
#pragma unroll
                for (int i = 0; i < 2; ++i) vo2[h][i] = last ? voN[h][i] : voC[h][i];
            PG8_LDB(B0, 0, 0); PG8_LDB(B1, 0, 1); PG8_SCHED; PG8_LDA(At, 0, 0); PG8_STAGE_A(PG8_SA(1, 1), k1, cA, voC, 1);
            PG8_WAIT_V(8); PG8_WAIT_L(0); PG8_BAR; PG8_MMA(0, 0, At, B0); PG8_MMA(0, 1, At, B1); PG8_BAR; PG8_SCHED;
            PG8_LDA(At, 0, 1); PG8_STAGE_B(PG8_SB(0, 0), b2); PG8_STAGE_B(PG8_SB(0, 1), b2 + hstep); PG8_STAGE_A(PG8_SA(0, 0), k2, u2, vo2, 0);
            PG8_WAIT_V(8); PG8_WAIT_L(0); PG8_BAR; PG8_MMA(1, 0, At, B0); PG8_MMA(1, 1, At, B1); PG8_BAR; PG8_SCHED;
            PG8_LDB(B0, 1, 0); PG8_LDB(B1, 1, 1); PG8_SCHED; PG8_LDA(At, 1, 0); PG8_STAGE_A(PG8_SA(0, 1), k2, u2, vo2, 1);
            PG8_WAIT_V(8); PG8_WAIT_L(0); PG8_BAR; PG8_MMA(0, 0, At, B0); PG8_MMA(0, 1, At, B1); PG8_BAR; PG8_SCHED;
            PG8_LDA(At, 1, 1); PG8_STAGE_B(PG8_SB(1, 0), b3); PG8_STAGE_B(PG8_SB(1, 1), b3 + hstep); PG8_STAGE_A(PG8_SA(1, 0), k3, u2, vo2, 0);
            PG8_WAIT_V(8); PG8_WAIT_L(0); PG8_BAR; PG8_MMA(1, 0, At, B0); PG8_MMA(1, 1, At, B1); PG8_BAR; PG8_SCHED;
        }
        if constexpr (ALIGN_EPI) { if (wr == 0) PG8_BAR; }
        if constexpr (!Epi::AFTER_DRAIN) { E(acc, cur, wr, wc, fr, fq); }
        if (!has_next) break;
#pragma unroll
        for (int a = 0; a < 2; ++a)
#pragma unroll
            for (int b = 0; b < 2; ++b)
#pragma unroll
                for (int m = 0; m < 4; ++m)
#pragma unroll
                    for (int n = 0; n < 2; ++n) acc[a][b][m][n] = (f32x4){0.f, 0.f, 0.f, 0.f};
        cur = nxt; cB = nB; cA = nA; ++ui;
#pragma unroll
        for (int h = 0; h < 2; ++h)
#pragma unroll
            for (int i = 0; i < 2; ++i) voC[h][i] = voN[h][i];
        if constexpr (ALIGN_EPI) { if (wr == 1) PG8_BAR; }
    }
    PG8_WAIT_V(0);
    if constexpr (!ALIGN_EPI) { if (wr == 0) PG8_BAR; }
    PG8_BAR;
    if constexpr (Epi::AFTER_DRAIN) { E.fused(acc, cur, wr, wc, fr, fq, lds, wid, lane); }
#undef PG8_SA
#undef PG8_SB
#undef PG8_STAGE_A
#undef PG8_STAGE_B
#undef PG8_LDA
#undef PG8_LDB
#undef PG8_MMA
#undef PG8_WAIT_V
#undef PG8_WAIT_L
#undef PG8_BAR
#undef PG8_SCHED
#undef PG8_SETVO
}
}

namespace da {
constexpr int QBLK = 32, KVBLK = 64, LDQ = NQKV;
constexpr int SHM_V = KVBLK * 128 * 2, SHM_K = KVBLK * 64 * 2;
constexpr int L_V = 0, L_K = 2 * SHM_V, L_WS = L_K + 2 * SHM_K, L_TAB = L_WS + NWAVES * 64 * 4, L_STASH = L_TAB + 640 * 4, L_ENDA = L_STASH + NWAVES * 32 * 64 * 4;
static_assert(L_ENDA <= RING_BYTES && (L_STASH % 16) == 0, "attention LDS map");
constexpr float THR = 8.f;
#define SBAR() __builtin_amdgcn_sched_barrier(0)
#define KSWZ64(row, colB) ((row) * 128 + ((colB) ^ ((((row) >> 1) & 7) << 4)))
__device__ __forceinline__ int crow(int r, int hi) { return (r & 3) + 8 * (r >> 2) + 4 * hi; }

__device__ __forceinline__ void partialSM(f32x16& p0, f32x16& p1, float& m_reg, float& alpha) {
    float pmax = p0[0];
#pragma unroll
    for (int r = 1; r < 16; ++r) pmax = fmaxf(pmax, p0[r]);
#pragma unroll
    for (int r = 0; r < 16; ++r) pmax = fmaxf(pmax, p1[r]);
    { auto rr = __builtin_amdgcn_permlane32_swap(__float_as_uint(pmax), __float_as_uint(pmax), false, false);
      pmax = fmaxf(__uint_as_float(rr[0]), __uint_as_float(rr[1])); }
    float mn;
    if (__builtin_expect(__all(pmax - m_reg <= THR), 1)) { mn = m_reg; alpha = 1.f; }
    else { mn = fmaxf(m_reg, pmax); alpha = __builtin_amdgcn_exp2f(m_reg - mn); m_reg = mn; }
#pragma unroll
    for (int r = 0; r < 16; ++r) p0[r] = p0[r] - mn;
#pragma unroll
    for (int r = 0; r < 16; ++r) p1[r] = p1[r] - mn;
#pragma unroll
    for (int r = 0; r < 16; ++r) p0[r] = __builtin_amdgcn_exp2f(p0[r]);
}
__device__ __forceinline__ void finishSM(f32x16& p0, f32x16& p1, float alpha, float& l_reg, bf16x8& pa0, bf16x8& pa1, bf16x8& pa2, bf16x8& pa3) {
#pragma unroll
    for (int r = 0; r < 16; ++r) p1[r] = __builtin_amdgcn_exp2f(p1[r]);
    float ps = 0;
#pragma unroll
    for (int r = 0; r < 16; ++r) ps += p0[r];
#pragma unroll
    for (int r = 0; r < 16; ++r) ps += p1[r];
    { auto rr = __builtin_amdgcn_permlane32_swap(__float_as_uint(ps), __float_as_uint(ps), false, false);
      ps = __uint_as_float(rr[0]) + __uint_as_float(rr[1]); }
    l_reg = l_reg * alpha + ps;
#define PK4(P, BASE, OUT) do { unsigned a0 = cvt_pk_bf16(P[BASE + 0], P[BASE + 1]), a1 = cvt_pk_bf16(P[BASE + 2], P[BASE + 3]);   \
    unsigned b0 = cvt_pk_bf16(P[BASE + 4], P[BASE + 5]), b1 = cvt_pk_bf16(P[BASE + 6], P[BASE + 7]);                              \
    auto r0 = __builtin_amdgcn_permlane32_swap(a0, b0, false, false); auto r1 = __builtin_amdgcn_permlane32_swap(a1, b1, false, false); \
    u32x4 w = {r0[0], r1[0], r0[1], r1[1]}; OUT = __builtin_bit_cast(bf16x8, w); } while (0)
    PK4(p0, 0, pa0); PK4(p0, 8, pa1); PK4(p1, 0, pa2); PK4(p1, 8, pa3);
#undef PK4
}
__device__ __forceinline__ void qkt(f32x16& p0, f32x16& p1, const LAS char* Ks, const bf16x8* qr, int r32, int hi) {
    p0 = f32x16{}; p1 = f32x16{};
#pragma unroll
    for (int d0 = 0; d0 < 4; ++d0) { const int cb = (d0 * 16 + hi * 8) * 2;
        const bf16x8 b0 = *(const LAS bf16x8*)(Ks + KSWZ64(r32, cb));
        const bf16x8 b1 = *(const LAS bf16x8*)(Ks + KSWZ64(32 + r32, cb));
        p0 = __builtin_amdgcn_mfma_f32_32x32x16_bf16(b0, qr[d0], p0, 0, 0, 0);
        p1 = __builtin_amdgcn_mfma_f32_32x32x16_bf16(b1, qr[d0], p1, 0, 0, 0); }
}
__device__ __forceinline__ int v_st(int k, int c) { const int kk = (k & ~0xC) | ((k & 4) << 1) | ((k & 8) >> 1); return ((kk >> 3) * 4 + (c >> 5)) * 512 + ((kk & 7) * 32 + (c & 31)) * 2; }
__device__ __forceinline__ int v_rd_base(int lane) { return ((lane & 3) << 3) | (((lane >> 2) & 3) << 6) | (((lane >> 4) & 1) << 5) | (((lane >> 5) & 1) << 8); }
constexpr int v_rd_off(int d0, int ks, int half) { return d0 * 512 + ks * 4096 + half * 2048; }
template <int OFF> __device__ __forceinline__ s16x4 tr_read(int vb) {
    s16x4 r; asm volatile("ds_read_b64_tr_b16 %0, %1 offset:%2" : "=&v"(r) : "v"(vb), "i"(OFF) : "memory"); return r;
}
template <int D0> __device__ __forceinline__ void pv_one(f32x16& od, int vb, bf16x8 pa0, bf16x8 pa1, bf16x8 pa2, bf16x8 pa3) {
    const s16x4 l0 = tr_read<v_rd_off(D0, 0, 0)>(vb), h0 = tr_read<v_rd_off(D0, 0, 1)>(vb), l1 = tr_read<v_rd_off(D0, 1, 0)>(vb), h1 = tr_read<v_rd_off(D0, 1, 1)>(vb);
    const s16x4 l2 = tr_read<v_rd_off(D0, 2, 0)>(vb), h2 = tr_read<v_rd_off(D0, 2, 1)>(vb), l3 = tr_read<v_rd_off(D0, 3, 0)>(vb), h3 = tr_read<v_rd_off(D0, 3, 1)>(vb);
    asm volatile("s_waitcnt lgkmcnt(0)" ::: "memory"); SBAR();
#define PK(L, H) (bf16x8){L[0], L[1], L[2], L[3], H[0], H[1], H[2], H[3]}
    od = __builtin_amdgcn_mfma_f32_32x32x16_bf16(pa0, PK(l0, h0), od, 0, 0, 0);
    od = __builtin_amdgcn_mfma_f32_32x32x16_bf16(pa1, PK(l1, h1), od, 0, 0, 0);
    od = __builtin_amdgcn_mfma_f32_32x32x16_bf16(pa2, PK(l2, h2), od, 0, 0, 0);
    od = __builtin_amdgcn_mfma_f32_32x32x16_bf16(pa3, PK(l3, h3), od, 0, 0, 0);
#undef PK
}
__device__ __forceinline__ void pv_d0(f32x16* o, int vb, bf16x8 pa0, bf16x8 pa1, bf16x8 pa2, bf16x8 pa3) {
    pv_one<0>(o[0], vb, pa0, pa1, pa2, pa3); pv_one<1>(o[1], vb, pa0, pa1, pa2, pa3); pv_one<2>(o[2], vb, pa0, pa1, pa2, pa3); pv_one<3>(o[3], vb, pa0, pa1, pa2, pa3);
}
__device__ __forceinline__ void biasmask(f32x16& p0, f32x16& p1, int base, int hi, const LAS float* tab) {
    const LAS float* tp = tab + (base + 256 - 4 * hi - 59);
    const int bl = base - 4 * hi;
#pragma unroll
    for (int r = 0; r < 16; ++r) { const int kk = (r & 3) + 8 * (r >> 2);
        p0[r] = (kk > bl) ? -INFINITY : p0[r] + tp[59 - kk];
        p1[r] = (kk + 32 > bl) ? -INFINITY : p1[r] + tp[59 - 32 - kk]; }
}

__device__ __forceinline__ void flash_pass(f32x16 (&o)[4], const bf16* __restrict__ Qw, const bf16* __restrict__ Kh, const bf16* __restrict__ Vh,
                                           int NT, int qabs, lds_u8* lds) {
    const int tid = tid_opaque(), wid = tid >> 6, lane = tid & 63, r32 = lane & 31, hi = lane >> 5;
    LAS char* V_lds = (LAS char*)(lds + L_V); LAS char* K_lds = (LAS char*)(lds + L_K);
    LAS float* ws = (LAS float*)(lds + L_WS) + wid * 64; LAS float* li_l = ws; LAS float* al_l = ws + 32;
    const LAS float* tab = (const LAS float*)(lds + L_TAB);
    float m_reg = -1e30f, l_reg = 0.f; bf16x8 qr[4];
#pragma unroll
    for (int d0 = 0; d0 < 4; ++d0) { o[d0] = f32x16{}; qr[d0] = *(const bf16x8*)(Qw + d0 * 16); }
    const int sr = tid >> 4, sc = (tid & 15) * 8, vst0 = v_st(sr, sc), vst1 = v_st(32 + sr, sc);
    const int kr = tid >> 3, kc = (tid & 7) * 8, kst = KSWZ64(kr, kc * 2);
    const int vb0 = (int)(uintptr_t)V_lds + v_rd_base(lane);
    struct { bf16x8 vs0, vs1, ks; } sr_[2];
#define SLOAD(i, k0) do { sr_[i].vs0 = *(const bf16x8*)(&Vh[(long)((k0) + sr) * LDQ + sc]); sr_[i].vs1 = *(const bf16x8*)(&Vh[(long)((k0) + 32 + sr) * LDQ + sc]); \
    sr_[i].ks = *(const bf16x8*)(&Kh[(long)((k0) + kr) * LDQ + kc]); } while (0)
#define SWRITE(b, i) do { *(LAS bf16x8*)(V_lds + (b) * SHM_V + vst0) = sr_[i].vs0; *(LAS bf16x8*)(V_lds + (b) * SHM_V + vst1) = sr_[i].vs1; \
    *(LAS bf16x8*)(K_lds + (b) * SHM_K + kst) = sr_[i].ks; } while (0)
#define SWAIT() asm volatile("s_waitcnt vmcnt(3)" ::: "memory")
#define RESC(a) do { if (__any((a) < 1.f)) { if (hi == 0) al_l[r32] = (a); asm volatile("s_waitcnt lgkmcnt(0)" ::: "memory"); \
    _Pragma("unroll") for (int d = 0; d < 4; ++d) _Pragma("unroll") for (int r = 0; r < 16; ++r) o[d][r] *= al_l[crow(r, hi)]; } } while (0)
#define BMASK(P0, P1, j) do { if ((j) >= NT - 6) biasmask(P0, P1, qabs - 64 * (j), hi, tab); } while (0)
    f32x16 pA0, pA1, pB0, pB1; float alA, alB; bf16x8 pa0, pa1, pa2, pa3;
    SLOAD(0, 0); asm volatile("s_waitcnt vmcnt(0)" ::: "memory"); SWRITE(0, 0); __syncthreads();
    qkt(pA0, pA1, K_lds, qr, r32, hi); BMASK(pA0, pA1, 0); partialSM(pA0, pA1, m_reg, alA);
    SLOAD(1, KVBLK); if (2 < NT) SLOAD(0, 2 * KVBLK);
    SWAIT(); SWRITE(1, 1); __syncthreads();
    for (int j = 1; j + 1 < NT; j += 2) {
        SBAR(); qkt(pB0, pB1, K_lds + SHM_K, qr, r32, hi);
        finishSM(pA0, pA1, alA, l_reg, pa0, pa1, pa2, pa3); SBAR();
        SLOAD(1, (j + 2) * KVBLK); SBAR();
        pv_d0(o, vb0, pa0, pa1, pa2, pa3); BMASK(pB0, pB1, j); partialSM(pB0, pB1, m_reg, alB);
        __syncthreads(); SWAIT(); SWRITE(0, 0);
        RESC(alB); __syncthreads();
        SBAR(); qkt(pA0, pA1, K_lds, qr, r32, hi);
        finishSM(pB0, pB1, alB, l_reg, pa0, pa1, pa2, pa3); SBAR();
        if (j + 3 < NT) SLOAD(0, (j + 3) * KVBLK); SBAR();
        pv_d0(o, vb0 + SHM_V, pa0, pa1, pa2, pa3); BMASK(pA0, pA1, j + 1); partialSM(pA0, pA1, m_reg, alA);
        __syncthreads(); SWAIT(); SWRITE(1, 1);
        RESC(alA); __syncthreads();
    }
    SBAR(); qkt(pB0, pB1, K_lds + SHM_K, qr, r32, hi);
    finishSM(pA0, pA1, alA, l_reg, pa0, pa1, pa2, pa3); SBAR();
    pv_d0(o, vb0, pa0, pa1, pa2, pa3); BMASK(pB0, pB1, NT - 1); partialSM(pB0, pB1, m_reg, alB);
    __syncthreads(); RESC(alB);
    finishSM(pB0, pB1, alB, l_reg, pa0, pa1, pa2, pa3); SBAR();
    pv_d0(o, vb0 + SHM_V, pa0, pa1, pa2, pa3);
    if (hi == 0) li_l[r32] = l_reg; asm volatile("s_waitcnt lgkmcnt(0)" ::: "memory");
#pragma unroll
    for (int r = 0; r < 16; ++r) { const float rl = __builtin_amdgcn_rcpf(li_l[crow(r, hi)]);
#pragma unroll
        for (int d = 0; d < 4; ++d) o[d][r] *= rl; }
    __syncthreads();
#undef SLOAD
#undef SWRITE
#undef SWAIT
#undef RESC
#undef BMASK
}

__device__ __forceinline__ void attn_unit(int b, int h, int qt, const bf16* qkv, bf16* ob, const float* dtab, const float* subg, float lam, lds_u8* lds) {
    const int tid = tid_opaque(), wid = tid >> 6, lane = tid & 63, r32 = lane & 31, hi = lane >> 5;
    LAS float* tab = (LAS float*)(lds + L_TAB);
    for (int i = tid; i < 640; i += NTHREADS) { const int d = i - 256; tab[i] = (d >= 0 && d < 128) ? dtab[h * 128 + d] : 0.f; }
    __syncthreads();
    const long rowbase = (long)b * SEQ; const int q0 = qt * 256; const int NT = 4 * qt + 4;
    const int qabs = q0 + wid * QBLK + r32;
    LAS unsigned* stash = (LAS unsigned*)(lds + L_STASH) + wid * (32 * 64) + lane;
    f32x16 o[4];
    { const bf16* Qw = qkv + (rowbase + qabs) * LDQ + h * 128 + hi * 8;
      const bf16* Kh = qkv + rowbase * LDQ + 1024 + h * 128;
      const bf16* Vh = qkv + rowbase * LDQ + 2048 + h * 128;
      flash_pass(o, Qw, Kh, Vh, NT, qabs, lds);
#pragma unroll
      for (int r = 0; r < 16; ++r) { stash[(2 * r) * 64] = cvt_pk_bf16(o[0][r], o[1][r]); stash[(2 * r + 1) * 64] = cvt_pk_bf16(o[2][r], o[3][r]); } }
    { const bf16* Qw = qkv + (rowbase + qabs) * LDQ + h * 128 + 64 + hi * 8;
      const bf16* Kh = qkv + rowbase * LDQ + 1024 + h * 128 + 64;
      const bf16* Vh = qkv + rowbase * LDQ + 2048 + h * 128;
      flash_pass(o, Qw, Kh, Vh, NT, qabs, lds); }
    LDS_WAIT();
    float gsc[4];
#pragma unroll
    for (int d = 0; d < 4; ++d) gsc[d] = subg[32 * d + r32] * 0.8f;
#pragma unroll
    for (int r = 0; r < 16; ++r) {
        const unsigned w0 = stash[(2 * r) * 64], w1 = stash[(2 * r + 1) * 64];
        const float v0 = bf_lo(w0) - lam * o[0][r], v1 = bf_hi(w0) - lam * o[1][r], v2 = bf_lo(w1) - lam * o[2][r], v3 = bf_hi(w1) - lam * o[3][r];
        float ss = (v0 * v0 + v1 * v1) + (v2 * v2 + v3 * v3);
        ss += __shfl_xor(ss, 1); ss += __shfl_xor(ss, 2); ss += __shfl_xor(ss, 4); ss += __shfl_xor(ss, 8); ss += __shfl_xor(ss, 16);
        const float rs = 1.0f / sqrtf(ss * (1.0f / 128.0f) + LN_EPS);
        bf16* op = ob + (rowbase + q0 + wid * QBLK + crow(r, hi)) * D + h * 128 + r32;
        op[0] = (bf16)(cvt_pk_bf16(v0 * rs * gsc[0], 0.f) & 0xffffu); op[32] = (bf16)(cvt_pk_bf16(v1 * rs * gsc[1], 0.f) & 0xffffu);
        op[64] = (bf16)(cvt_pk_bf16(v2 * rs * gsc[2], 0.f) & 0xffffu); op[96] = (bf16)(cvt_pk_bf16(v3 * rs * gsc[3], 0.f) & 0xffffu);
    }
    __syncthreads();
}
}

namespace sg {
constexpr int L_VT = 0;
constexpr int L_ST = 65536;
__device__ __forceinline__ void chunk_unit(int ch, bf16* U, const bf16* V, const float* lng, const float* lnb, const bf16* wtril, const float* bs, lds_u8* lds) {
    const int tid = tid_opaque(), wid = tid >> 6, lane = tid & 63, r32 = lane & 31, hi = lane >> 5;
    const long R0 = (long)ch * SGC;
    LAS float* st = (LAS float*)(lds + L_ST);
    for (int i = 0; i < 16; ++i) { const int row = wid * 16 + i; const bf16* vr = V + (R0 + row) * SGH + lane * 8;
        float s = 0.f, q = 0.f;
#pragma unroll
        for (int j = 0; j < 6; ++j) { const u32x4 w = *(const u32x4*)(vr + j * 512);
#pragma unroll
            for (int k = 0; k < 4; ++k) { const float a = bf_lo(w[k]), b = bf_hi(w[k]); s += a + b; q += a * a + b * b; } }
        s = wave_sum(s); q = wave_sum(q);
        const float mu = s * (1.0f / SGH); const float var = fmaxf(q * (1.0f / SGH) - mu * mu, 0.f);
        if (lane == 0) { st[row * 2] = mu; st[row * 2 + 1] = 1.0f / sqrtf(var + LN_EPS); } }
    __syncthreads();
    const int sr = tid >> 4, sc = (tid & 15) * 8;
    const int rb = wid & 3, chh = wid >> 2;
    for (int sl = 0; sl < 24; ++sl) {
        const int g = sl / 3, c0 = sl * 128; const int buf = sl & 1;
        LAS char* vt = (LAS char*)(lds + L_VT + buf * 32768);
        { f32x4 ga = *(const f32x4*)(lng + c0 + sc), gb = *(const f32x4*)(lng + c0 + sc + 4), ba = *(const f32x4*)(lnb + c0 + sc), bb = *(const f32x4*)(lnb + c0 + sc + 4);
#pragma unroll
          for (int i = 0; i < 4; ++i) { const int row = sr + 32 * i; const u32x4 w = *(const u32x4*)(V + (R0 + row) * SGH + c0 + sc);
              const float mu = st[row * 2], rs = st[row * 2 + 1];
              u32x4 o;
              o.x = cvt_pk_bf16((bf_lo(w.x) - mu) * rs * ga[0] + ba[0], (bf_hi(w.x) - mu) * rs * ga[1] + ba[1]);
              o.y = cvt_pk_bf16((bf_lo(w.y) - mu) * rs * ga[2] + ba[2], (bf_hi(w.y) - mu) * rs * ga[3] + ba[3]);
              o.z = cvt_pk_bf16((bf_lo(w.z) - mu) * rs * gb[0] + bb[0], (bf_hi(w.z) - mu) * rs * gb[1] + bb[1]);
              o.w = cvt_pk_bf16((bf_lo(w.w) - mu) * rs * gb[2] + bb[2], (bf_hi(w.w) - mu) * rs * gb[3] + bb[3]);
              *(LAS u32x4*)(vt + (row >> 6) * 16384 + da::v_st(row & 63, sc)) = o; } }
        __syncthreads();
        f32x16 o0 = f32x16{}, o1 = f32x16{};
        const bf16* wrow = wtril + ((size_t)g * 128 + rb * 32 + r32) * 128 + hi * 8;
        const int vb = (int)(uintptr_t)vt + da::v_rd_base(lane);
#pragma unroll
        for (int kt = 0; kt < 2; ++kt) {
            if (kt == 0 || rb >= 2) {
                const bf16x8 pa0 = *(const bf16x8*)(wrow + kt * 64), pa1 = *(const bf16x8*)(wrow + kt * 64 + 16), pa2 = *(const bf16x8*)(wrow + kt * 64 + 32), pa3 = *(const bf16x8*)(wrow + kt * 64 + 48);
                if (chh == 0) { da::pv_one<0>(o0, vb + kt * 16384, pa0, pa1, pa2, pa3); da::pv_one<1>(o1, vb + kt * 16384, pa0, pa1, pa2, pa3); }
                else          { da::pv_one<2>(o0, vb + kt * 16384, pa0, pa1, pa2, pa3); da::pv_one<3>(o1, vb + kt * 16384, pa0, pa1, pa2, pa3); }
            }
        }
#pragma unroll
        for (int r = 0; r < 16; ++r) { const int t = rb * 32 + da::crow(r, hi); const float bt = bs[g * 128 + t];
            bf16* up = U + (R0 + t) * SGH + c0 + chh * 64 + r32;
            const float u0 = __uint_as_float((unsigned)up[0] << 16), u1 = __uint_as_float((unsigned)up[32] << 16);
            up[0] = (bf16)(cvt_pk_bf16(u0 * (o0[r] + bt), 0.f) & 0xffffu); up[32] = (bf16)(cvt_pk_bf16(u1 * (o1[r] + bt), 0.f) & 0xffffu); }
    }
    __syncthreads();
}
}

#define XB_TMO      128
#define XB_XCNT(j)  (256  + 64 * (j))
#define XB_XSUB(j)  (1280 + 64 * (j))
#define XB_XGEN(j)  (2304 + 64 * (j))
#define XB_TOP      3328
#define XB_TOPGEN   3392
#define XCD_BAR_WORDS 3456
#define XB_SPIN_CAP (1u << 22)
__device__ __forceinline__ unsigned xb_ld(unsigned* p)              { return __hip_atomic_load(p, __ATOMIC_RELAXED, __HIP_MEMORY_SCOPE_AGENT); }
__device__ __forceinline__ unsigned xb_add(unsigned* p, unsigned v) { return __hip_atomic_fetch_add(p, v, __ATOMIC_RELAXED, __HIP_MEMORY_SCOPE_AGENT); }
__device__ __forceinline__ unsigned xb_xcc_id() { return (unsigned)__builtin_amdgcn_s_getreg((3 << 11) | 20) & 0xFu; }
#define XB_SPIN(cond, bar) do { unsigned _sp = 0; while (cond) { __builtin_amdgcn_s_sleep(1); \
    if ((++_sp & 255u) == 0u) { if (xb_ld(&(bar)[XB_TMO])) break; if (_sp > XB_SPIN_CAP) { atomicAdd(&(bar)[XB_TMO], 1u); break; } } } } while (0)
struct XcdBarrier { unsigned* bar; unsigned x; volatile LAS unsigned* st; };
__device__ __forceinline__ XcdBarrier xcd_barrier_post(unsigned* bar, volatile LAS unsigned* st) {
    XcdBarrier b; b.bar = bar; b.x = xb_xcc_id(); b.st = st;
    if (threadIdx.x == 0) (void)xb_add(&bar[XB_XCNT(b.x)], 1u);
    return b;
}
__device__ __forceinline__ void xcd_barrier_complete(unsigned* bar, unsigned x, unsigned& nloc, unsigned& nx) {
    const unsigned G = gridDim.x * gridDim.y * gridDim.z;
    unsigned sum, cnt, mine, sp = 0u;
    for (;;) {
        sum = 0u; cnt = 0u; mine = 0u;
#pragma unroll
        for (unsigned j = 0; j < 16; ++j) { const unsigned c = xb_ld(&bar[XB_XCNT(j)]); sum += c; cnt += (c > 0u) ? 1u : 0u; mine = (j == x) ? c : mine; }
        if (sum == G) break;
        __builtin_amdgcn_s_sleep(1);
        if ((++sp & 255u) == 0u) { if (xb_ld(&bar[XB_TMO])) break; if (sp > XB_SPIN_CAP) { atomicAdd(&bar[XB_TMO], 1u); break; } }
    }
    nloc = mine > 0u ? mine : 1u; nx = cnt > 0u ? cnt : 1u;
}
__device__ __forceinline__ void xcd_barrier(const XcdBarrier& b) {
    asm volatile("s_waitcnt vmcnt(0)" ::: "memory");
    __syncthreads();
    if (threadIdx.x == 0) {
        unsigned* bar = b.bar;
        __builtin_amdgcn_s_waitcnt(0);
        unsigned nloc = b.st[0], nx = b.st[1];
        if (nloc == 0u) { xcd_barrier_complete(bar, b.x, nloc, nx); b.st[0] = nloc; b.st[1] = nx; }
        const unsigned old = xb_add(&bar[XB_XSUB(b.x)], 1u);
        const unsigned gen = old / nloc;
        if (old + 1u == (gen + 1u) * nloc) {
            __builtin_amdgcn_fence(__ATOMIC_RELEASE, "agent");
            asm volatile("s_waitcnt vmcnt(0)" ::: "memory");
            const unsigned og = xb_add(&bar[XB_TOP], 1u);
            const unsigned tg = og / nx;
            if (og + 1u == (tg + 1u) * nx) xb_add(&bar[XB_TOPGEN], 1u);
            else XB_SPIN(xb_ld(&bar[XB_TOPGEN]) == tg, bar);
            __builtin_amdgcn_fence(__ATOMIC_ACQUIRE, "agent");
            xb_add(&bar[XB_XGEN(b.x)], 1u);
            asm volatile("s_waitcnt vmcnt(0)" ::: "memory");
        } else {
            XB_SPIN(xb_ld(&bar[XB_XGEN(b.x)]) == gen, bar);
            __builtin_amdgcn_fence(__ATOMIC_ACQUIRE, "agent");
            asm volatile("s_waitcnt vmcnt(0)" ::: "memory");
        }
    }
    __syncthreads();
}

__device__ __forceinline__ void transpose_item(const float* W, int N, bf16* WT, int ldk, int row_off, int k0, int n0, LAS float* scr, int lane) {
#pragma unroll 8
    for (int i = 0; i < 32; ++i) { const int kk = 2 * i + (lane >> 5); scr[kk * 33 + (lane & 31)] = W[(size_t)(k0 + kk) * N + n0 + (lane & 31)]; }
    LDS_WAIT(); asm volatile("" ::: "memory");
    const int c = lane & 7;
#pragma unroll
    for (int j = 0; j < 4; ++j) { const int n = (lane >> 3) + 8 * j; const LAS float* s = scr + (8 * c) * 33 + n;
        u32x4 o; o.x = cvt_pk_bf16(s[0 * 33], s[1 * 33]); o.y = cvt_pk_bf16(s[2 * 33], s[3 * 33]); o.z = cvt_pk_bf16(s[4 * 33], s[5 * 33]); o.w = cvt_pk_bf16(s[6 * 33], s[7 * 33]);
        *(u32x4*)(WT + (size_t)(row_off + n) * ldk + k0 + 8 * c) = o; }
    LDS_WAIT(); asm volatile("" ::: "memory");
}
__device__ __forceinline__ void transpose_matrix(const float* W, int K, int N, bf16* WT, LAS float* scr, int gw, int ngw, int lane) {
    const int nblk = N / 32, nitems = (K / 64) * nblk;
    for (int it = gw; it < nitems; it += ngw) { const int kb = it / nblk, nb = it % nblk; transpose_item(W, N, WT, K, 32 * nb, 64 * kb, 32 * nb, scr, lane); }
}
__device__ __forceinline__ void convert_moe(const float* wg, const float* wu, const float* wd, bf16* B1, bf16* B2, LAS float* scr, int gw, int ngw, int lane) {
    constexpr int IPE = 3 * 256;
    for (int it = gw; it < NEXP * IPE; it += ngw) {
        const int e = it / IPE, r = it % IPE, m = r >> 8, q = r & 255;
        if (m < 2) { const int kb = q >> 4, nb = q & 15; const int n0 = 32 * nb;
            const float* W = (m == 0 ? wg : wu) + (size_t)e * D * MOEH;
            const int row_off = (n0 >> 7) * 256 + m * 128 + (n0 & 127);
            transpose_item(W, MOEH, B1 + (size_t)e * D * D, D, row_off, 64 * kb, n0, scr, lane); }
        else { const int kb = q >> 5, nb = q & 31;
            transpose_item(wd + (size_t)e * MOEH * D, D, B2 + (size_t)e * D * MOEH, MOEH, 32 * nb, 64 * kb, 32 * nb, scr, lane); }
    }
}
__device__ __forceinline__ int t5_bucket(int n) {
    if (n < 16) return n;
    int large = 16 + (int)(logf((float)n / 16.0f) / logf(8.0f) * 16.0f);
    return large < 31 ? large : 31;
}

__device__ __forceinline__ void ln_store16(float (&v)[16], const float* g, const float* b, float* orow, bf16* brow, int lane) {
    float s = 0.f;
#pragma unroll
    for (int i = 0; i < 16; ++i) s += v[i];
    const float mean = wave_sum(s) * (1.f / D); float s2 = 0.f;
#pragma unroll
    for (int i = 0; i < 16; ++i) { v[i] -= mean; s2 += v[i] * v[i]; }
    const float rstd = 1.f / sqrtf(wave_sum(s2) * (1.f / D) + LN_EPS);
#pragma unroll
    for (int j = 0; j < 2; ++j) { const int c = 8 * lane + 512 * j;
        const f32x4 g0 = *(const f32x4*)(g + c), g1 = *(const f32x4*)(g + c + 4), b0 = *(const f32x4*)(b + c), b1 = *(const f32x4*)(b + c + 4);
        f32x4 y0, y1;
#pragma unroll
        for (int k = 0; k < 4; ++k) { y0[k] = v[8 * j + k] * rstd * g0[k] + b0[k]; y1[k] = v[8 * j + 4 + k] * rstd * g1[k] + b1[k]; }
        if (orow) { *(f32x4*)(orow + c) = y0; *(f32x4*)(orow + c + 4) = y1; }
        if (brow) { u32x4 w; w.x = cvt_pk_bf16(y0[0], y0[1]); w.y = cvt_pk_bf16(y0[2], y0[3]); w.z = cvt_pk_bf16(y1[0], y1[1]); w.w = cvt_pk_bf16(y1[2], y1[3]); *(u32x4*)(brow + c) = w; } }
}
__device__ __forceinline__ void unpack8(const u32x4 w, float* v) { v[0] = bf_lo(w.x); v[1] = bf_hi(w.x); v[2] = bf_lo(w.y); v[3] = bf_hi(w.y); v[4] = bf_lo(w.z); v[5] = bf_hi(w.z); v[6] = bf_lo(w.w); v[7] = bf_hi(w.w); }

#ifndef PROBE_P0
#define PROBE_P0 1
#endif
#ifndef PROBE_ATTN
#define PROBE_ATTN 1
#endif
#ifndef PROBE_NOSTORE
#define PROBE_NOSTORE 0
#endif
#ifndef PROBE_QKV
#define PROBE_QKV 1
#endif
#ifndef PROBE_WO
#define PROBE_WO 1
#endif
#ifndef PROBE_GIN
#define PROBE_GIN 1
#endif
#ifndef PROBE_MOE
#define PROBE_MOE 1
#endif
#ifndef PHASES
#define PHASES 0xFFFF
#endif
#define PH(k) ((PHASES >> (k)) & 1)
struct Params { const float* in[22]; float* out; unsigned char* ws; };
enum { I_X = 0, I_RELB, I_AWIN, I_AWOUT, I_ALAM, I_ASUBG, I_SGWIN, I_SGBIN, I_SGLNG, I_SGLNB, I_SGWS, I_SGBS, I_SGWOUT,
       I_MWG, I_MBG, I_MWR, I_MBR, I_MWGATE, I_MWUP, I_MWDOWN, I_LNG, I_LNB };
typedef const __attribute__((address_space(4))) Params* kparams_t;
#define KP() ({ kparams_t _k = (kparams_t)__builtin_amdgcn_kernarg_segment_ptr(); asm volatile("" : "+s"(_k)); _k; })

__global__ void __launch_bounds__(NTHREADS, 2) mega_fwd(Params p_unused) {
    extern __shared__ __attribute__((aligned(16))) unsigned char lds_raw[];
    lds_u8* lds = (lds_u8*)lds_raw;
    const int G = gridDim.x, bx = blockIdx.x;
#define PHASE_IDS() const int tid = tid_opaque(), lane = tid & 63, wave = __builtin_amdgcn_readfirstlane(tid >> 6); (void)lane; (void)wave; \
    const int gw = vcu * NWAVES + wave, ngw = G * NWAVES, gtid = bx * NTHREADS + tid, ngt = G * NTHREADS; (void)gw; (void)ngw; (void)gtid; (void)ngt
    const int vcu = (G % 8 == 0) ? (bx % 8) * (G / 8) + bx / 8 : bx;
    for (int u = threadIdx.x; u < (LDS_BYTES - LDSCTL_OFF) / 4; u += NTHREADS) ((LAS unsigned*)(lds + LDSCTL_OFF))[u] = 0u;
    __syncthreads();
    XcdBarrier bar;
    { kparams_t kp = KP(); bar = xcd_barrier_post((unsigned*)(kp->ws + WS_CTL) + 4096, (volatile LAS unsigned*)(lds + L_MISC)); }
#define GRID_BAR() xcd_barrier(bar)

#pragma unroll 1
    for (int rep_ = 0; rep_ < PROBE_P0; ++rep_)
    if (PH(0)) {
        PHASE_IDS(); kparams_t kp = KP(); unsigned char* ws = kp->ws;
        LAS float* scr = (LAS float*)(lds + wave * 16384);
        transpose_matrix(kp->in[I_AWIN], D, NQKV, (bf16*)(ws + WS_WQKV), scr, gw, ngw, lane);
        transpose_matrix(kp->in[I_AWOUT], D, D, (bf16*)(ws + WS_WO), scr, gw, ngw, lane);
        transpose_matrix(kp->in[I_SGWIN], D, 2 * SGH, (bf16*)(ws + WS_W1), scr, gw, ngw, lane);
        transpose_matrix(kp->in[I_SGWOUT], SGH, D, (bf16*)(ws + WS_W2), scr, gw, ngw, lane);
        convert_moe(kp->in[I_MWGATE], kp->in[I_MWUP], kp->in[I_MWDOWN], (bf16*)(ws + WS_MOE1), (bf16*)(ws + WS_MOE2), scr, gw, ngw, lane);
        { const float* wgp = kp->in[I_MWG]; const float* wrp = kp->in[I_MWR]; bf16* wr_t = (bf16*)(ws + WS_WR);
          for (int i = gtid; i < 2 * 256 * D; i += ngt) { const int l = i / (256 * D), n = (i / D) % 256, k = i % D;
              float v = 0.f; if (n < 8) v = wgp[(size_t)l * D * 8 + k * 8 + n]; else if (n < 72) v = wrp[(size_t)l * D * 64 + k * 64 + (n - 8)];
              wr_t[i] = (bf16)(cvt_pk_bf16(v, 0.f) & 0xffffu); } }
        { const float* w_s = kp->in[I_SGWS]; bf16* wtril = (bf16*)(ws + WS_WTRIL);
          for (int i = gtid; i < SGG * SGC * SGC; i += ngt) { const int t = (i / SGC) % SGC, s_ = i % SGC; const float v = (s_ <= t) ? w_s[i] : 0.f; wtril[i] = (bf16)(cvt_pk_bf16(v, 0.f) & 0xffffu); } }
        { const float* rel_bias = kp->in[I_RELB]; float* dtab = (float*)(ws + WS_DTAB);
          for (int i = gtid; i < NHEAD * 128; i += ngt) { const int h = i / 128, d = i % 128; dtab[i] = (rel_bias[t5_bucket(d) * NHEAD + h] - rel_bias[31 * NHEAD + h]) * LOG2E; } }
        { const float* x = kp->in[I_X]; bf16* hb = (bf16*)(ws + WS_HB);
          for (size_t i = gtid; i < (size_t)NTOK * D / 8; i += ngt) { const f32x4 a = *(const f32x4*)(x + i * 8), b = *(const f32x4*)(x + i * 8 + 4);
              u32x4 w; w.x = cvt_pk_bf16(a.x, a.y); w.y = cvt_pk_bf16(a.z, a.w); w.z = cvt_pk_bf16(b.x, b.y); w.w = cvt_pk_bf16(b.z, b.w); *(u32x4*)(hb + i * 8) = w; } }
    }
    GRID_BAR();

#pragma unroll 1
    for (int layer = 0; layer < 2; ++layer) {
        if (layer == 0) {
            _Pragma("unroll 1") for (int rep_ = 0; rep_ < PROBE_QKV; ++rep_)
            if (PH(1)) { kparams_t kp = KP(); unsigned char* ws = kp->ws;
              pg8::Gemm g{(const bf16*)(ws + WS_HB), (const bf16*)(ws + WS_WQKV), D, 0}; pg8::StaticOrder S{NTOK / 256, NQKV / 256, G, bx};
              pg8::EpiBf16<0> E{(bf16*)(ws + WS_QKV), NQKV, nullptr, D, (size_t)D, 0.125f * LOG2E, PROBE_NOSTORE ? rep_ : 0};
              pg8::gemm_phase<pg8::EpiBf16<0>, pg8::StaticOrder, true, false>(lds, g, S, E); }
#ifdef PROBE_NULLQKV
            { kparams_t kp = KP(); unsigned char* ws = kp->ws;
              pg8::Gemm g{(const bf16*)(ws + WS_HB), (const bf16*)(ws + WS_WQKV), D, 0}; pg8::StaticOrder S{NTOK / 256, NQKV / 256, G, bx};
              pg8::EpiNull E{(f32x4*)(ws + WS_OB)};
              pg8::gemm_phase<pg8::EpiNull, pg8::StaticOrder, true, false>(lds, g, S, E); }
#endif
            GRID_BAR();
            if (PH(2)) { PHASE_IDS(); kparams_t kp = KP(); unsigned char* ws = kp->ws;
              float lam;
              { const float* al = kp->in[I_ALAM]; const float a = al[lane] * al[64 + lane], b = al[128 + lane] * al[192 + lane];
                lam = __expf(wave_sum(a)) - __expf(wave_sum(b)) + 0.2f; }
              const int bh = vcu >> 1, half = vcu & 1;
#pragma unroll 1
              for (int i = 0; i < 8 * PROBE_ATTN; ++i) { const int s_ = 2 * ((i & 7) >> 1) + half; const int qt = (i & 1) ? 15 - s_ : s_;
                  da::attn_unit(bh >> 3, bh & 7, qt, (const bf16*)(ws + WS_QKV), (bf16*)(ws + WS_OB), (const float*)(ws + WS_DTAB), kp->in[I_ASUBG], lam, lds); } }
            GRID_BAR();
            _Pragma("unroll 1") for (int rep_ = 0; rep_ < PROBE_WO; ++rep_)
            if (PH(3)) { kparams_t kp = KP(); unsigned char* ws = kp->ws;
              pg8::Gemm g{(const bf16*)(ws + WS_OB), (const bf16*)(ws + WS_WO), D, 0}; pg8::StaticOrder S{NTOK / 256, D / 256, G, bx};
              pg8::EpiResBf16 E{(const bf16*)(ws + WS_HB), (bf16*)(ws + WS_HB), D, DN_ALPHA};
              pg8::gemm_phase<pg8::EpiResBf16, pg8::StaticOrder, true, false>(lds, g, S, E); }
            GRID_BAR();
        } else {
            _Pragma("unroll 1") for (int rep_ = 0; rep_ < PROBE_GIN; ++rep_)
            if (PH(4)) { kparams_t kp = KP(); unsigned char* ws = kp->ws;
              pg8::Gemm g{(const bf16*)(ws + WS_HB), (const bf16*)(ws + WS_W1), D, 0}; pg8::StaticOrder S{NTOK / 256, 2 * SGH / 256, G, bx};
              pg8::EpiBf16<1> E{(bf16*)(ws + WS_U), SGH, kp->in[I_SGBIN], SGH, (size_t)(WS_V - WS_U) / 2, 1.f, PROBE_NOSTORE ? rep_ : 0};
              pg8::gemm_phase<pg8::EpiBf16<1>, pg8::StaticOrder, true, false>(lds, g, S, E); }
            GRID_BAR();
            if (PH(5)) { kparams_t kp = KP(); unsigned char* ws = kp->ws;
#pragma unroll 1
              for (int ch = bx; ch < NTOK / SGC; ch += G)
                  sg::chunk_unit(ch, (bf16*)(ws + WS_U), (const bf16*)(ws + WS_V), kp->in[I_SGLNG], kp->in[I_SGLNB], (const bf16*)(ws + WS_WTRIL), kp->in[I_SGBS], lds); }
            GRID_BAR();
            if (PH(6)) { PHASE_IDS(); kparams_t kp = KP(); unsigned char* ws = kp->ws;
              LAS float* scr = (LAS float*)(lds + wave * 16384);
              convert_moe(kp->in[I_MWGATE] + (size_t)NEXP * D * MOEH, kp->in[I_MWUP] + (size_t)NEXP * D * MOEH, kp->in[I_MWDOWN] + (size_t)NEXP * MOEH * D,
                          (bf16*)(ws + WS_MOE1), (bf16*)(ws + WS_MOE2), scr, gw, ngw, lane);
              __syncthreads(); }
            if (PH(6)) { kparams_t kp = KP(); unsigned char* ws = kp->ws;
              pg8::Gemm g{(const bf16*)(ws + WS_U), (const bf16*)(ws + WS_W2), SGH, 0}; pg8::StaticOrder S{NTOK / 256, D / 256, G, bx};
              pg8::EpiResBf16 E{(const bf16*)(ws + WS_HB), (bf16*)(ws + WS_HB), D, DN_ALPHA};
              pg8::gemm_phase<pg8::EpiResBf16, pg8::StaticOrder, true, false>(lds, g, S, E); }
            GRID_BAR();
        }
        if (PH(7)) {
            PHASE_IDS();
            { kparams_t kp = KP(); unsigned char* ws = kp->ws; bf16* hb = (bf16*)(ws + WS_HB);
              const float* g1 = kp->in[I_LNG] + (size_t)(layer * 2 + 0) * D; const float* b1 = kp->in[I_LNB] + (size_t)(layer * 2 + 0) * D;
#pragma unroll 1
              for (int i = 0; i < 32; i += 2) { const size_t row = (size_t)bx * 256 + wave * 32 + i; bf16* r0 = hb + row * D; bf16* r1 = r0 + D; float va[16], vb[16];
                  const u32x4 a0 = *(const u32x4*)(r0 + 8 * lane), a1 = *(const u32x4*)(r0 + 8 * lane + 512), c0 = *(const u32x4*)(r1 + 8 * lane), c1 = *(const u32x4*)(r1 + 8 * lane + 512);
                  unpack8(a0, va); unpack8(a1, va + 8); unpack8(c0, vb); unpack8(c1, vb + 8);
                  ln_store16(va, g1, b1, nullptr, r0, lane); ln_store16(vb, g1, b1, nullptr, r1, lane); }
              VM_WAIT(); __builtin_amdgcn_fence(__ATOMIC_ACQUIRE, "agent"); VM_WAIT(); __syncthreads(); }
            { kparams_t kp = KP(); unsigned char* ws = kp->ws;
              pg8::Gemm g{(const bf16*)(ws + WS_HB), (const bf16*)(ws + WS_WR) + (size_t)layer * 256 * D, D, 0}; pg8::SingleOrder S{bx};
              pg8::EpiRouter E{kp->in[I_MBG] + layer * 8, kp->in[I_MBR] + layer * 64};
              pg8::gemm_phase<pg8::EpiRouter, pg8::SingleOrder, false, false>(lds, g, S, E); }
            LAS int* wcnt = (LAS int*)(lds + L_WCNT);
            if (tid < 64) wcnt[tid] = 0;
            __syncthreads();
            if (tid < 256) { kparams_t kp = KP(); unsigned char* ws = kp->ws; int* aexp = (int*)(ws + WS_AEXP); float* agate = (float*)(ws + WS_AGATE);
                const LAS float* lg = (const LAS float*)lds + tid * 73;
                float gmax = lg[0]; int gi = 0;
#pragma unroll
                for (int j = 1; j < 8; ++j) { const float v = lg[j]; if (v > gmax) { gmax = v; gi = j; } }
                float gs = 0.f;
#pragma unroll
                for (int j = 0; j < 8; ++j) gs += __expf(lg[j] - gmax);
                const float ggate = 1.0f / gs;
                const LAS float* el = lg + 8 + gi * 8;
                float v1 = el[0]; int i1 = 0;
#pragma unroll
                for (int j = 1; j < 8; ++j) { const float v = el[j]; if (v > v1) { v1 = v; i1 = j; } }
                float v2 = -INFINITY; int i2 = 0;
#pragma unroll
                for (int j = 0; j < 8; ++j) { const float v = el[j]; if (j != i1 && v > v2) { v2 = v; i2 = j; } }
                const float e2 = __expf(v2 - v1), p1 = 1.0f / (1.0f + e2), p2 = e2 * p1;
                const int tok = bx * 256 + tid; const int e1x = gi * 8 + i1, e2x = gi * 8 + i2;
                aexp[2 * tok] = e1x; aexp[2 * tok + 1] = e2x; agate[2 * tok] = ggate * p1; agate[2 * tok + 1] = ggate * p2;
                atomicAdd((int*)&wcnt[e1x], 1); atomicAdd((int*)&wcnt[e2x], 1); }
            __syncthreads();
            if (tid < 64) { kparams_t kp = KP(); int* hist = (int*)(kp->ws + WS_HIST); hist[bx * 64 + tid] = wcnt[tid]; }
        }
        GRID_BAR();
        LAS int* pstL = (LAS int*)(lds + L_PST);
        if (PH(8)) {
            PHASE_IDS(); kparams_t kp = KP(); unsigned char* ws = kp->ws; const int* hist = (const int*)(ws + WS_HIST); const int* aexp = (const int*)(ws + WS_AEXP); unsigned* srt = (unsigned*)(ws + WS_SRT);
            LAS int* cntL = (LAS int*)(lds + L_CNT);
            LAS int* offsL = (LAS int*)(lds + L_OFFS); LAS int* wcnt = (LAS int*)(lds + L_WCNT); LAS int* part = (LAS int*)(lds + L_PART);
            { const int e = tid & 63, pt = tid >> 6; int sa = 0, sb = 0;
              for (int w = pt * 32; w < pt * 32 + 32; ++w) { const int hv = hist[w * 64 + e]; sa += hv; if (w < bx) sb += hv; }
              part[pt * 64 + e] = sa; part[512 + pt * 64 + e] = sb; }
            __syncthreads();
            if (tid < 64) { int sa = 0, sb = 0;
#pragma unroll
                for (int pt = 0; pt < 8; ++pt) { sa += part[pt * 64 + tid]; sb += part[512 + pt * 64 + tid]; }
                cntL[tid] = sa; offsL[tid] = sb; wcnt[tid] = 0; }
            __syncthreads();
            if (tid == 0) { int acc = 0; for (int e = 0; e < 64; ++e) { pstL[e] = acc; acc += (cntL[e] + 255) & ~255; } pstL[64] = acc; pstL[65] = acc; pstL[66] = acc; pstL[67] = acc; }
            __syncthreads();
            if (tid < 256) { const int tok = bx * 256 + tid;
#pragma unroll
                for (int k = 0; k < 2; ++k) { const int a = 2 * tok + k; const int e = aexp[a]; const int rank = atomicAdd((int*)&wcnt[e], 1);
                    srt[pstL[e] + offsL[e] + rank] = (unsigned)a; } }
            if (bx < 64) { const int e = bx; const int c = cntL[e], cp = (c + 255) & ~255; for (int i = c + tid; i < cp; i += NTHREADS) srt[pstL[e] + i] = SRT_MARK; }
        }
        GRID_BAR();
        _Pragma("unroll 1") for (int rep_ = 0; rep_ < PROBE_MOE; ++rep_)
            if (PH(9)) { kparams_t kp = KP(); unsigned char* ws = kp->ws; const int ntile = pstL[64] >> 8;
          pg8::Gemm g{(const bf16*)(ws + WS_HB), (const bf16*)(ws + WS_MOE1), D, (size_t)D * D * 2}; pg8::MoeOrder S{ntile, G, bx, pstL, (const unsigned*)(ws + WS_SRT), true};
          pg8::EpiSwiglu E{(bf16*)(ws + WS_HM)};
          pg8::gemm_phase<pg8::EpiSwiglu, pg8::MoeOrder, true, true>(lds, g, S, E); }
        GRID_BAR();
        _Pragma("unroll 1") for (int rep_ = 0; rep_ < PROBE_MOE; ++rep_)
            if (PH(10)) { kparams_t kp = KP(); unsigned char* ws = kp->ws; const int ntile = pstL[64] >> 8;
          pg8::Gemm g{(const bf16*)(ws + WS_HM), (const bf16*)(ws + WS_MOE2), MOEH, (size_t)D * MOEH * 2}; pg8::MoeOrder S{ntile, G, bx, pstL, (const unsigned*)(ws + WS_SRT), false};
          pg8::EpiScatter E{(bf16*)(ws + WS_YSLOT), (const unsigned*)(ws + WS_SRT), (const float*)(ws + WS_AGATE)};
          pg8::gemm_phase<pg8::EpiScatter, pg8::MoeOrder, true, false>(lds, g, S, E); }
        GRID_BAR();
        if (PH(11)) {
            PHASE_IDS(); kparams_t kp = KP(); unsigned char* ws = kp->ws; float* out = kp->out; bf16* hb = (bf16*)(ws + WS_HB); const bf16* yslot = (const bf16*)(ws + WS_YSLOT);
            const float* g2 = kp->in[I_LNG] + (size_t)(layer * 2 + 1) * D; const float* b2 = kp->in[I_LNB] + (size_t)(layer * 2 + 1) * D;
#pragma unroll 1
            for (int i = 0; i < 32; ++i) { const size_t row = (size_t)bx * 256 + wave * 32 + i; bf16* hr = hb + row * D; float v[16];
                const bf16* y0 = yslot + (2 * row) * D, * y1 = y0 + D;
#pragma unroll
                for (int j = 0; j < 2; ++j) { const int c = 8 * lane + 512 * j; float h8[8], a8[8], b8[8];
                    unpack8(*(const u32x4*)(hr + c), h8); unpack8(*(const u32x4*)(y0 + c), a8); unpack8(*(const u32x4*)(y1 + c), b8);
#pragma unroll
                    for (int k = 0; k < 8; ++k) v[8 * j + k] = h8[k] * DN_ALPHA + (a8[k] + b8[k]); }
                if (layer == 0) ln_store16(v, g2, b2, nullptr, hr, lane); else ln_store16(v, g2, b2, out + row * D, nullptr, lane); }
        }
        if (layer == 0) GRID_BAR();
    }
}

extern "C" void kernel_launch(void* const* d_in, const int* in_sizes, int n_in, void* d_out, int out_size, void* d_ws, size_t ws_size, hipStream_t stream) {
    static int ok = 0;
    if (ok == 0) {
        if (n_in != 22 || in_sizes[0] != NTOK * D || out_size != NTOK * D || ws_size < WS_END) {
            fprintf(stderr, "kernel_launch: shape mismatch: n_in %d in0 %d out %d ws %zu (need %zu)\n", n_in, n_in > 0 ? in_sizes[0] : -1, out_size, ws_size, (size_t)WS_END); ok = -1; return; }
        if (hipFuncSetAttribute((const void*)mega_fwd, hipFuncAttributeMaxDynamicSharedMemorySize, LDS_BYTES) != hipSuccess) { fprintf(stderr, "kernel_launch: hipFuncSetAttribute failed\n"); ok = -1; return; }
        int per_cu = 0;
        if (hipOccupancyMaxActiveBlocksPerMultiprocessor(&per_cu, (const void*)mega_fwd, NTHREADS, LDS_BYTES) != hipSuccess || per_cu < 1)
            fprintf(stderr, "kernel_launch: occupancy query reports %d workgroups per CU\n", per_cu);
        (void)hipGetLastError();
        ok = 1;
    }
    if (ok < 0) return;
    if (hipMemsetAsync((char*)d_ws + WS_CTL, 0, CTL_ZERO_BYTES, stream) != hipSuccess) { fprintf(stderr, "kernel_launch: memset failed\n"); return; }
    Params p{};
    for (int i = 0; i < 22; ++i) p.in[i] = (const float*)d_in[i];
    p.out = (float*)d_out; p.ws = (unsigned char*)d_ws;
    hipLaunchKernelGGL(mega_fwd, dim3(GRID), dim3(NTHREADS), LDS_BYTES, stream, p);
    const hipError_t le = hipPeekAtLastError();
    if (le != hipSuccess) fprintf(stderr, "kernel_launch: launch failed: %s\n", hipGetErrorName(le));
}
```

```cpp
#ifndef ACT_ON
#define ACT_ON 1
#endif
#include <hip/hip_runtime.h>
#include <hip/hip_bf16.h>
#include <cstdio>
#include <cstdint>

#define LAS __attribute__((address_space(3)))
#define GAS __attribute__((address_space(1)))
typedef unsigned short bf16;
typedef short bf16x8 __attribute__((ext_vector_type(8)));
typedef short s16x4 __attribute__((ext_vector_type(4)));
typedef float f32x4 __attribute__((ext_vector_type(4)));
typedef float f32x2 __attribute__((ext_vector_type(2)));
typedef float f32x16 __attribute__((ext_vector_type(16)));
typedef unsigned u32x4 __attribute__((ext_vector_type(4)));
typedef unsigned u32x2 __attribute__((ext_vector_type(2)));
typedef LAS unsigned char lds_u8;

constexpr int D = 1024, BATCH = 16, SEQ = 4096, NTOK = BATCH * SEQ;
constexpr int NQKV = 3072, NHEAD = 8;
constexpr int SGH = 3072, SGG = 8, SGC = 128, SGGD = 384;
constexpr int NEXP = 64, MOEH = 512, NASG = NTOK * 2;
constexpr int PMAX = NASG + NEXP * 256;
constexpr float LN_EPS = 1e-5f, DN_ALPHA = 1.4142135623730951f;
constexpr float LOG2E = 1.4426950408889634f;
constexpr unsigned SRT_MARK = 0xFFFFFFFFu;
constexpr float YSCALE = 16.0f, YINV = 1.0f / 16.0f;
constexpr int NWAVES = 8, NTHREADS = 512, GRID = 256;

constexpr size_t MiB = 1u << 20;
constexpr size_t WS_CTL = 0, CTL_ZERO_BYTES = 1 * MiB;
constexpr size_t WS_DTAB = 1 * MiB;
constexpr size_t WS_WTRIL = 1 * MiB + 65536;
constexpr size_t WS_WR = 2 * MiB;
constexpr size_t WS_HIST = 3 * MiB;
constexpr size_t WS_AEXP = 4 * MiB;
constexpr size_t WS_AGATE = 5 * MiB;
constexpr size_t WS_SRT = 6 * MiB;
constexpr size_t WS_WQKV = 8 * MiB;
constexpr size_t WS_WO = 14 * MiB;
constexpr size_t WS_W1 = 16 * MiB;
constexpr size_t WS_W2 = 28 * MiB;
constexpr size_t WS_HB = 34 * MiB;
constexpr size_t WS_ARENA = 162 * MiB;
constexpr size_t WS_QKV = WS_ARENA;
constexpr size_t WS_OB = WS_ARENA + 384 * MiB;
constexpr size_t WS_YSLOT = WS_ARENA;
constexpr size_t WS_HM = WS_ARENA + 256 * MiB;
constexpr size_t WS_U = WS_ARENA;
constexpr size_t WS_V = WS_ARENA + 384 * MiB;
constexpr size_t WS_MOE1 = WS_ARENA + 576 * MiB;
constexpr size_t WS_MOE2 = WS_MOE1 + 128 * MiB;
constexpr size_t WS_VSTAT = WS_MOE2 + 64 * MiB;
constexpr size_t WS_END = WS_VSTAT + 26 * MiB;
static_assert(WS_HM + (size_t)PMAX * MOEH * 2 <= WS_MOE1, "ws map");
static_assert(WS_V + (size_t)NTOK * SGH * 2 <= WS_END, "ws map");

constexpr int RING_BYTES = 131072;
constexpr int LDSCTL_OFF = 139264;
constexpr int L_MISC = LDSCTL_OFF;
constexpr int L_CNT = LDSCTL_OFF + 64;
constexpr int L_PST = L_CNT + 256;
constexpr int L_OFFS = L_PST + 272;
constexpr int L_WCNT = L_OFFS + 256;
constexpr int L_PART = L_WCNT + 256;
constexpr int L_END = L_PART + 4096;
constexpr int LDS_BYTES = 147456;
static_assert(L_END <= LDS_BYTES, "LDS map");

__device__ __forceinline__ unsigned cvt_pk_bf16(float lo, float hi) { unsigned r; asm volatile("v_cvt_pk_bf16_f32 %0, %1, %2" : "=v"(r) : "v"(lo), "v"(hi)); return r; }
__device__ __forceinline__ float clamp_e4m3(float x) { return __builtin_amdgcn_fmed3f(x, -448.0f, 448.0f); }
__device__ __forceinline__ unsigned pk4_fp8(float a, float b, float c, float d) { int w = 0; w = __builtin_amdgcn_cvt_pk_fp8_f32(clamp_e4m3(a), clamp_e4m3(b), w, false); w = __builtin_amdgcn_cvt_pk_fp8_f32(clamp_e4m3(c), clamp_e4m3(d), w, true); return (unsigned)w; }
__device__ __forceinline__ float bf_lo(unsigned w) { return __uint_as_float(w << 16); }
__device__ __forceinline__ float bf_hi(unsigned w) { return __uint_as_float(w & 0xffff0000u); }
__device__ __forceinline__ float wave_sum(float v) {
#define WS_DPP(X, CTRL, RM) __builtin_bit_cast(float, __builtin_amdgcn_update_dpp(0, __builtin_bit_cast(int, X), CTRL, RM, 0xf, false))
    v += WS_DPP(v, 0xB1, 0xf);
    v += WS_DPP(v, 0x4E, 0xf);
    v += WS_DPP(v, 0x141, 0xf);
    v += WS_DPP(v, 0x140, 0xf);
    v += WS_DPP(v, 0x142, 0xa);
    v += WS_DPP(v, 0x143, 0xc);
#undef WS_DPP
    return __builtin_bit_cast(float, __builtin_amdgcn_readlane(__builtin_bit_cast(int, v), 63));
}
__device__ __forceinline__ float gelu_tanh(float x) {
    const float inner = x * (1.0f + 0.044715f * x * x);
    const float e = __builtin_amdgcn_exp2f(-2.302208198f * inner);
    return x * __builtin_amdgcn_rcpf(1.0f + e);
}
__device__ __forceinline__ f32x2 gelu_tanh2(f32x2 x) {
    const f32x2 x2 = x * x, inner = x * (x2 * (-2.302208198f * 0.044715f) + (-2.302208198f));
    f32x2 e; e.x = __builtin_amdgcn_exp2f(inner.x); e.y = __builtin_amdgcn_exp2f(inner.y);
    const f32x2 d = e + 1.0f; f32x2 r; r.x = __builtin_amdgcn_rcpf(d.x); r.y = __builtin_amdgcn_rcpf(d.y);
    return x * r;
}
__device__ __forceinline__ float silu_f(float x) { return x * __builtin_amdgcn_rcpf(1.0f + __builtin_amdgcn_exp2f(-LOG2E * x)); }
__device__ __forceinline__ int lane_id() { int l; asm volatile("v_mbcnt_lo_u32_b32 %0, -1, 0\n\tv_mbcnt_hi_u32_b32 %0, -1, %0" : "=v"(l)); return l; }
__device__ __forceinline__ int tid_opaque(int wv) { int t = wv * 64 + lane_id(); asm volatile("" : "+v"(t)); return t; }
#define GLOAD16(DST, PTR, OFF) asm volatile("global_load_dwordx4 %0, %1, off offset:" #OFF : "=&v"(DST) : "v"(PTR) : "memory")
#define GLOAD8(DST, PTR, OFF) asm volatile("global_load_dwordx2 %0, %1, off offset:" #OFF : "=&v"(DST) : "v"(PTR) : "memory")
#define GLOAD4(DST, PTR, OFF) asm volatile("global_load_dword %0, %1, off offset:" #OFF : "=&v"(DST) : "v"(PTR) : "memory")
#define LDS_WAIT() asm volatile("s_waitcnt lgkmcnt(0)" ::: "memory")
#define VM_WAIT() asm volatile("s_waitcnt vmcnt(0)" ::: "memory")

namespace pg8 {
constexpr int BM = 256, BK = 64, HALF = 128, HTB = HALF * BK * 2, STAGE_BYTES = 8 * HTB, NXCD = 8, WGM = 8;
__device__ __forceinline__ int lds_byte(int r, int c) { const int st = (r >> 4) * 2 + (c >> 5), rr = r & 15, cc = c & 31, ob = rr * 64 + cc * 2; return st * 1024 + (ob ^ (((ob >> 9) & 1) << 5)); }
__device__ __forceinline__ void stage_rc(int b, int& R, int& C) { const int st = b / 1024, sb = b % 1024, swz = sb ^ (((sb >> 9) & 1) << 5); R = (st >> 1) * 16 + swz / 64; C = (st & 1) * 32 + (swz % 64) / 2; }
__device__ __forceinline__ int perm32(int rho) { const int n = rho >> 4, i = rho & 15; return 8 * (i >> 2) + 4 * n + (i & 3); }

struct Unit { int pm, pn, e; };
struct Gemm { const bf16* A; const bf16* Bt; int K; size_t bstride; };

__device__ __forceinline__ bool static_tile(int i, int G, int c, int nM, int nN, int& pm, int& pn) {
    const int nwg = nM * nN; const long L = (long)i * G + c; if (L >= nwg) return false;
    int wgid = (int)L; { const int q = nwg / NXCD, r = nwg % NXCD, xcd = wgid % NXCD, off = wgid / NXCD; wgid = (xcd < r ? xcd * (q + 1) : r * (q + 1) + (xcd - r) * q) + off; }
    const int nig = WGM * nN, gid = wgid / nig, fm = gid * WGM, gsz = (nM - fm) < WGM ? (nM - fm) : WGM;
    pm = fm + ((wgid % nig) % gsz); pn = (wgid % nig) / gsz; return true;
}
struct StaticOrder {
    int nM, nN, G, c;
    __device__ __forceinline__ bool next(int i, Unit& u) const { u.e = 0; return static_tile(i, G, c, nM, nN, u.pm, u.pn); }
    __device__ __forceinline__ unsigned arow(const Unit& u, int r) const { return (unsigned)(u.pm * BM + r); }
};
struct RowOrder {
    int pm, nN;
    __device__ __forceinline__ bool next(int i, Unit& u) const { u.e = 0; u.pm = pm; u.pn = i; return i < nN; }
    __device__ __forceinline__ unsigned arow(const Unit& u, int r) const { return (unsigned)(u.pm * BM + r); }
};
struct SingleOrder {
    int pm;
    __device__ __forceinline__ bool next(int i, Unit& u) const { u.e = 0; u.pm = pm; u.pn = 0; return i == 0; }
    __device__ __forceinline__ unsigned arow(const Unit& u, int r) const { return (unsigned)(u.pm * BM + r); }
};
struct MoeOrder {
    int nM, G, c; const LAS int* pst; const unsigned* srt; bool gather;
    __device__ __forceinline__ bool next(int i, Unit& u) const {
        if (!static_tile(i, G, c, nM, 4, u.pm, u.pn)) return false;
        const int x = u.pm * BM, lane = lane_id();
        const int lo = pst[lane], hi = pst[lane + 1];
        const unsigned long long m = __ballot(lo <= x && x < hi);
        u.e = __builtin_amdgcn_readfirstlane(m ? __builtin_ctzll(m) : 0);
        return true;
    }
    __device__ __forceinline__ unsigned arow(const Unit& u, int r) const {
        if (!gather) return (unsigned)(u.pm * BM + r);
        const unsigned a = srt[u.pm * BM + r]; return a == SRT_MARK ? 0u : (a >> 1);
    }
};

template <int ACT> struct EpiBf16 {
    static constexpr int PERM = 2; static constexpr bool AFTER_DRAIN = false;
    bf16* O; int ldc; const float* bias; int split_cols; size_t split_stride; float scale0; int nostore; f32x2* vstat;
    __device__ __forceinline__ void operator()(const f32x4 (&acc)[2][2][4][2], const Unit& u, int wr, int wc, int fr, int fq) const {
        const int row0 = u.pm * BM + wr * 64 + fr; int colt = u.pn * BM; bf16* base = O;
        float sc = 1.f; int tsp = 0; if (split_cols) { const int t = colt / split_cols; tsp = t; base += (size_t)t * split_stride; colt -= t * split_cols; if (t == 0) sc = scale0; }
        const int col0 = colt + wc * 64 + 16 * fq, bcol0 = u.pn * BM + wc * 64 + 16 * fq;
        f32x4 bv[2][2];
#pragma unroll
        for (int bj = 0; bj < 2; ++bj)
#pragma unroll
            for (int n = 0; n < 2; ++n) bv[bj][n] = bias ? *(const f32x4*)(bias + bcol0 + 8 * bj + 4 * n) : (f32x4){0.f, 0.f, 0.f, 0.f};
#pragma unroll
        for (int ai = 0; ai < 2; ++ai)
#pragma unroll
            for (int m = 0; m < 4; ++m) { bf16* rowp = base + (size_t)(row0 + ai * HALF + m * 16) * ldc + col0; float rs_ = 0.f, rq_ = 0.f;
#pragma unroll
                for (int bj = 0; bj < 2; ++bj) { f32x4 v0 = acc[ai][bj][m][0] + bv[bj][0], v1 = acc[ai][bj][m][1] + bv[bj][1];
                    if (ACT == 1 && tsp == 1) {
#pragma unroll
                        for (int j = 0; j < 4; j += 2) { const f32x2 a = gelu_tanh2((f32x2){v0[j], v0[j + 1]}), b = gelu_tanh2((f32x2){v1[j], v1[j + 1]});
                            v0[j] = a.x; v0[j + 1] = a.y; v1[j] = b.x; v1[j + 1] = b.y; rs_ += (a.x + a.y) + (b.x + b.y); rq_ += (a.x * a.x + a.y * a.y) + (b.x * b.x + b.y * b.y); } }
                    v0 = v0 * sc; v1 = v1 * sc; u32x4 w; w.x = cvt_pk_bf16(v0[0], v0[1]); w.y = cvt_pk_bf16(v0[2], v0[3]); w.z = cvt_pk_bf16(v1[0], v1[1]); w.w = cvt_pk_bf16(v1[2], v1[3]);
                    if (!nostore) *(u32x4*)(rowp + 8 * bj) = w; }
                if (ACT == 1 && tsp == 1) { rs_ += __shfl_xor(rs_, 16); rq_ += __shfl_xor(rq_, 16); rs_ += __shfl_xor(rs_, 32); rq_ += __shfl_xor(rq_, 32);
                    if (fq == 0) vstat[(size_t)(row0 + ai * HALF + m * 16) * 48 + (colt >> 8) * 4 + wc] = (f32x2){rs_, rq_}; } }
    }
};
struct EpiNull {
    static constexpr int PERM = 1; static constexpr bool AFTER_DRAIN = false; f32x4* O;
    __device__ __forceinline__ void operator()(const f32x4 (&acc)[2][2][4][2], const Unit& u, int wr, int wc, int fr, int fq) const {
#pragma unroll
        for (int ai = 0; ai < 2; ++ai)
#pragma unroll
            for (int bj = 0; bj < 2; ++bj)
#pragma unroll
                for (int m = 0; m < 4; ++m)
#pragma unroll
                    for (int n = 0; n < 2; ++n) if (u.pm == 0x7fffffff) O[(((ai * 2 + bj) * 4 + m) * 2 + n) * 4096 + fr * 64 + fq * 16 + wc * 4 + wr] = acc[ai][bj][m][n];
    }
};
struct EpiResF32 {
    static constexpr int PERM = 0; static constexpr bool AFTER_DRAIN = false;
    const float* res; float* out; int ldc; float alpha;
    __device__ __forceinline__ void operator()(const f32x4 (&acc)[2][2][4][2], const Unit& u, int wr, int wc, int fr, int fq) const {
        const int col0 = u.pn * BM + wc * 32 + 4 * fq;
#pragma unroll
        for (int ai = 0; ai < 2; ++ai)
#pragma unroll
            for (int m = 0; m < 4; ++m) { const size_t off = (size_t)(u.pm * BM + ai * HALF + wr * 64 + m * 16 + fr) * ldc + col0;
#pragma unroll
                for (int bj = 0; bj < 2; ++bj)
#pragma unroll
                    for (int n = 0; n < 2; ++n) { const f32x4 r = *(const f32x4*)(res + off + bj * HALF + n * 16); *(f32x4*)(out + off + bj * HALF + n * 16) = r * alpha + acc[ai][bj][m][n]; } }
    }
};
struct EpiResBf16 {
    static constexpr int PERM = 2; static constexpr bool AFTER_DRAIN = false;
    const bf16* res; bf16* out; int ldc; float alpha;
    __device__ __forceinline__ void operator()(const f32x4 (&acc)[2][2][4][2], const Unit& u, int wr, int wc, int fr, int fq) const {
        const int col0 = u.pn * BM + wc * 64 + 16 * fq;
        u32x4 rn[2];
        { const size_t off = (size_t)(u.pm * BM + wr * 64 + fr) * ldc + col0; rn[0] = *(const u32x4*)(res + off); rn[1] = *(const u32x4*)(res + off + 8); }
#pragma unroll
        for (int k = 0; k < 8; ++k) { const int ai = k >> 2, m = k & 3; const size_t off = (size_t)(u.pm * BM + ai * HALF + wr * 64 + m * 16 + fr) * ldc + col0;
            u32x4 r[2] = {rn[0], rn[1]};
            if (k + 1 < 8) { const int ai2 = (k + 1) >> 2, m2 = (k + 1) & 3; const size_t off2 = (size_t)(u.pm * BM + ai2 * HALF + wr * 64 + m2 * 16 + fr) * ldc + col0;
                rn[0] = *(const u32x4*)(res + off2); rn[1] = *(const u32x4*)(res + off2 + 8); asm volatile("" : "+v"(rn[0]), "+v"(rn[1])); }
#pragma unroll
            for (int bj = 0; bj < 2; ++bj) { const u32x4 rr = r[bj];
                const f32x4 a0 = acc[ai][bj][m][0], a1 = acc[ai][bj][m][1]; u32x4 w;
                w.x = cvt_pk_bf16(bf_lo(rr.x) * alpha + a0[0], bf_hi(rr.x) * alpha + a0[1]); w.y = cvt_pk_bf16(bf_lo(rr.y) * alpha + a0[2], bf_hi(rr.y) * alpha + a0[3]);
                w.z = cvt_pk_bf16(bf_lo(rr.z) * alpha + a1[0], bf_hi(rr.z) * alpha + a1[1]); w.w = cvt_pk_bf16(bf_lo(rr.w) * alpha + a1[2], bf_hi(rr.w) * alpha + a1[3]);
                *(u32x4*)(out + off + 8 * bj) = w; } }
    }
};
struct EpiRouter {
    static constexpr int PERM = 0; static constexpr bool AFTER_DRAIN = true;
    const float* bg; const float* br;
    __device__ __forceinline__ void fused(f32x4 (&acc)[2][2][4][2], const Unit& u, int wr, int wc, int fr, int fq, lds_u8* lds, int wid, int lane) const {
        LAS float* L = (LAS float*)lds;
        if (wc < 3) {
#pragma unroll
            for (int n = 0; n < 2; ++n) { const int c0 = wc * 32 + 16 * n + 4 * fq;
#pragma unroll
                for (int j = 0; j < 4; ++j) { const int c = c0 + j; if (c < 72) { const float b = c < 8 ? bg[c] : br[c - 8];
#pragma unroll
                    for (int ai = 0; ai < 2; ++ai)
#pragma unroll
                        for (int m = 0; m < 4; ++m) L[(ai * HALF + wr * 64 + m * 16 + fr) * 73 + c] = acc[ai][0][m][n][j] + b; } } } }
    }
};
struct EpiSwiglu {
    static constexpr int PERM = 1; static constexpr bool AFTER_DRAIN = false;
    bf16* O;
    __device__ __forceinline__ void operator()(const f32x4 (&acc)[2][2][4][2], const Unit& u, int wr, int wc, int fr, int fq) const {
        const int col0 = u.pn * 128 + wc * 32 + 8 * fq;
#pragma unroll
        for (int ai = 0; ai < 2; ++ai)
#pragma unroll
            for (int m = 0; m < 4; ++m) { bf16* rowp = O + (size_t)(u.pm * BM + ai * HALF + wr * 64 + m * 16 + fr) * MOEH + col0;
                float o[8];
#pragma unroll
                for (int n = 0; n < 2; ++n)
#pragma unroll
                    for (int j = 0; j < 4; ++j) o[4 * n + j] = silu_f(acc[ai][0][m][n][j]) * acc[ai][1][m][n][j];
                u32x4 w; w.x = cvt_pk_bf16(o[0], o[1]); w.y = cvt_pk_bf16(o[2], o[3]); w.z = cvt_pk_bf16(o[4], o[5]); w.w = cvt_pk_bf16(o[6], o[7]);
                *(u32x4*)rowp = w; }
    }
};
struct EpiScatter {
    static constexpr int PERM = 2; static constexpr bool AFTER_DRAIN = false;
    unsigned char* Y; const unsigned* srt; const float* gate;
    __device__ __forceinline__ void operator()(const f32x4 (&acc)[2][2][4][2], const Unit& u, int wr, int wc, int fr, int fq) const {
        const int col0 = u.pn * BM + wc * 64 + 16 * fq;
        unsigned a8[8]; float g8[8];
#pragma unroll
        for (int k = 0; k < 8; ++k) a8[k] = srt[u.pm * BM + (k >> 2) * HALF + wr * 64 + (k & 3) * 16 + fr];
#pragma unroll
        for (int k = 0; k < 8; ++k) g8[k] = gate[a8[k] == SRT_MARK ? 0u : a8[k]] * YSCALE;
#pragma unroll
        for (int k = 0; k < 8; ++k) { const int ai = k >> 2, m = k & 3; const unsigned a = a8[k];
            if (a != SRT_MARK) { const float gt = g8[k];
                const f32x4 p0 = acc[ai][0][m][0] * gt, p1 = acc[ai][0][m][1] * gt, p2 = acc[ai][1][m][0] * gt, p3 = acc[ai][1][m][1] * gt;
                u32x4 w; w.x = pk4_fp8(p0[0], p0[1], p0[2], p0[3]); w.y = pk4_fp8(p1[0], p1[1], p1[2], p1[3]); w.z = pk4_fp8(p2[0], p2[1], p2[2], p2[3]); w.w = pk4_fp8(p3[0], p3[1], p3[2], p3[3]);
                *(u32x4*)(Y + (size_t)a * D + col0) = w; } }
    }
};
template <class Epi, class Sched, bool ALIGN_EPI, bool GATHER>
__device__ __forceinline__ void gemm_phase(lds_u8* lds, const Gemm g, const Sched& S, const Epi& E, int wv) {
    const int tid = tid_opaque(wv), wid = __builtin_amdgcn_readfirstlane(tid >> 6), lane = tid & 63, wr = wid >> 2, wc = wid & 3, fr = lane & 15, fq = lane >> 4;
    const int K = g.K, nt = K / BK;
    unsigned voffB[2], voffA[2]; int Rl[2], Cl[2];
#pragma unroll
    for (int i = 0; i < 2; ++i) { int R, C; stage_rc(tid * 16 + i * 8192, R, C);
        const int Rb = (int)Epi::PERM == 2 ? (64 * (R >> 5) + 16 * ((R >> 2) & 3) + 4 * ((R >> 4) & 1) + (R & 3)) : ((int)Epi::PERM == 1 ? ((R & ~31) + perm32(R & 31)) : R);
        Rl[i] = R; Cl[i] = C; voffA[i] = (unsigned)(R * K + C) * 2u; voffB[i] = (unsigned)(Rb * K + C) * 2u; }
    const size_t kstep = (size_t)(BK * 2);
    const size_t hstep = (size_t)HALF * K * 2;
    const size_t hstepB = (size_t)((int)Epi::PERM == 2 ? 8 : HALF) * K * 2;
    const size_t tstep = 2 * hstep;
    const unsigned ldsw = (unsigned)wid * 1024u;
    const int aoff = lds_byte(wr * 64 + fr, fq * 8), boff = lds_byte(wc * 32 + fr, fq * 8);
    const char* const Ab = (const char*)g.A;
#define PG8_SA(b, h) (((b) * 2 + (h)) * HTB)
#define PG8_SB(b, h) ((4 + (b) * 2 + (h)) * HTB)
#define PG8_STAGE_B(bufoff, gbase) do { _Pragma("unroll") for (int _i = 0; _i < 2; ++_i) \
        __builtin_amdgcn_global_load_lds((const unsigned*)((const char*)(gbase) + voffB[_i]), (LAS unsigned*)(lds + (bufoff) + ldsw + _i * 8192), 16, 0, 0); } while (0)
#define PG8_STAGE_A(bufoff, kb, ub, vo, h) do { _Pragma("unroll") for (int _i = 0; _i < 2; ++_i) { \
        const char* _src = GATHER ? (Ab + (kb) + (vo)[h][_i]) : ((ub) + (kb) + (size_t)(h) * hstep + voffA[_i]); \
        __builtin_amdgcn_global_load_lds((const unsigned*)_src, (LAS unsigned*)(lds + (bufoff) + ldsw + _i * 8192), 16, 0, 0); } } while (0)
#define PG8_LDA(dst, b, h) do { _Pragma("unroll") for (int m = 0; m < 4; ++m) _Pragma("unroll") for (int k = 0; k < 2; ++k) dst[m][k] = *(const LAS bf16x8*)(lds + PG8_SA(b, h) + aoff + m * 2048 + k * 1024); } while (0)
#define PG8_LDB(dst, b, h) do { _Pragma("unroll") for (int n = 0; n < 2; ++n) _Pragma("unroll") for (int k = 0; k < 2; ++k) dst[n][k] = *(const LAS bf16x8*)(lds + PG8_SB(b, h) + boff + n * 2048 + k * 1024); } while (0)
#define PG8_MMA(ai, bj, At, Bt) do { __builtin_amdgcn_s_setprio(1); _Pragma("unroll") for (int m = 0; m < 4; ++m) _Pragma("unroll") for (int n = 0; n < 2; ++n) _Pragma("unroll") for (int k = 0; k < 2; ++k) \
        acc[ai][bj][m][n] = __builtin_amdgcn_mfma_f32_16x16x32_bf16(Bt[n][k], At[m][k], acc[ai][bj][m][n], 0, 0, 0); __builtin_amdgcn_s_setprio(0); } while (0)
#define PG8_WAIT_V(n) asm volatile("s_waitcnt vmcnt(" #n ")" ::: "memory")
#define PG8_WAIT_L(n) asm volatile("s_waitcnt lgkmcnt(" #n ")" ::: "memory")
#define PG8_BAR __builtin_amdgcn_s_barrier()
#define PG8_SCHED __builtin_amdgcn_sched_barrier(0)
#define PG8_SETVO(vo, u) do { if constexpr (GATHER) { _Pragma("unroll") for (int _h = 0; _h < 2; ++_h) _Pragma("unroll") for (int _i = 0; _i < 2; ++_i) \
        (vo)[_h][_i] = (S.arow((u), _h * HALF + Rl[_i]) * (unsigned)K + (unsigned)Cl[_i]) * 2u; \
        asm volatile("" : "+v"((vo)[0][0]), "+v"((vo)[0][1]), "+v"((vo)[1][0]), "+v"((vo)[1][1])); } } while (0)
    Unit cur, nxt; int ui = 0;
    if (!S.next(0, cur)) return;
    unsigned voC[2][2], voN[2][2];
#pragma unroll
    for (int h = 0; h < 2; ++h)
#pragma unroll
        for (int i = 0; i < 2; ++i) { voC[h][i] = 0u; voN[h][i] = 0u; }
    PG8_SETVO(voC, cur);
    const char* cA = GATHER ? Ab : Ab + (size_t)cur.pm * tstep;
    f32x4 acc[2][2][4][2];
#pragma unroll
    for (int a = 0; a < 2; ++a)
#pragma unroll
        for (int b = 0; b < 2; ++b)
#pragma unroll
            for (int m = 0; m < 4; ++m)
#pragma unroll
                for (int n = 0; n < 2; ++n) acc[a][b][m][n] = (f32x4){0.f, 0.f, 0.f, 0.f};
    bf16x8 At[4][2], B0[2][2], B1[2][2];
    const char* cB = (const char*)g.Bt + (size_t)cur.e * g.bstride + (size_t)cur.pn * tstep;
    PG8_STAGE_B(PG8_SB(0, 0), cB); PG8_STAGE_B(PG8_SB(0, 1), cB + hstepB); PG8_STAGE_A(PG8_SA(0, 0), 0, cA, voC, 0); PG8_STAGE_A(PG8_SA(0, 1), 0, cA, voC, 1);
    if (wr == 1) PG8_BAR;
    PG8_WAIT_V(2); PG8_BAR;
    PG8_STAGE_B(PG8_SB(1, 0), cB + kstep); PG8_STAGE_A(PG8_SA(1, 0), kstep, cA, voC, 0); PG8_STAGE_B(PG8_SB(1, 1), cB + hstepB + kstep);
    PG8_WAIT_V(6); PG8_BAR;
    for (;;) {
        const bool has_next = S.next(ui + 1, nxt);
        if (has_next) { PG8_SETVO(voN, nxt); }
        else {
#pragma unroll
            for (int h = 0; h < 2; ++h)
#pragma unroll
                for (int i = 0; i < 2; ++i) voN[h][i] = voC[h][i]; }
        const char* nB = has_next ? (const char*)g.Bt + (size_t)nxt.e * g.bstride + (size_t)nxt.pn * tstep : cB;
        const char* nA = (has_next && !GATHER) ? Ab + (size_t)nxt.pm * tstep : cA;
        for (int t = 0; t < nt; t += 2) {
            const bool last = (t == nt - 2);
            const size_t k1 = (size_t)(t + 1) * kstep;
            const size_t k2 = last ? 0 : (size_t)(t + 2) * kstep, k3 = k2 + kstep; const char* u2 = last ? nA : cA;
            const char* b2 = last ? nB : cB + (size_t)(t + 2) * kstep;
            const char* b3 = b2 + kstep;
            unsigned vo2[2][2];
#pragma unroll
            for (int h = 0; h < 2; ++h)
#pragma unroll
                for (int i = 0; i < 2; ++i) vo2[h][i] = last ? voN[h][i] : voC[h][i];
            PG8_LDB(B0, 0, 0); PG8_LDB(B1, 0, 1); PG8_SCHED; PG8_LDA(At, 0, 0); PG8_STAGE_A(PG8_SA(1, 1), k1, cA, voC, 1);
            PG8_WAIT_V(8); PG8_WAIT_L(0); PG8_BAR; PG8_MMA(0, 0, At, B0); PG8_MMA(0, 1, At, B1); PG8_BAR; PG8_SCHED;
            PG8_LDA(At, 0, 1); PG8_STAGE_B(PG8_SB(0, 0), b2); PG8_STAGE_B(PG8_SB(0, 1), b2 + hstepB); PG8_STAGE_A(PG8_SA(0, 0), k2, u2, vo2, 0);
            PG8_WAIT_V(8); PG8_WAIT_L(0); PG8_BAR; PG8_MMA(1, 0, At, B0); PG8_MMA(1, 1, At, B1); PG8_BAR; PG8_SCHED;
            PG8_LDB(B0, 1, 0); PG8_LDB(B1, 1, 1); PG8_SCHED; PG8_LDA(At, 1, 0); PG8_STAGE_A(PG8_SA(0, 1), k2, u2, vo2, 1);
            PG8_WAIT_V(8); PG8_WAIT_L(0); PG8_BAR; PG8_MMA(0, 0, At, B0); PG8_MMA(0, 1, At, B1); PG8_BAR; PG8_SCHED;
            PG8_LDA(At, 1, 1); PG8_STAGE_B(PG8_SB(1, 0), b3); PG8_STAGE_B(PG8_SB(1, 1), b3 + hstepB); PG8_STAGE_A(PG8_SA(1, 0), k3, u2, vo2, 0);
            PG8_WAIT_V(8); PG8_WAIT_L(0); PG8_BAR; PG8_MMA(1, 0, At, B0); PG8_MMA(1, 1, At, B1); PG8_BAR; PG8_SCHED;
        }
        if constexpr (ALIGN_EPI) { if (wr == 0) PG8_BAR; }
        if constexpr (!Epi::AFTER_DRAIN) { E(acc, cur, wr, wc, fr, fq); }
        if (!has_next) break;
#pragma unroll
        for (int a = 0; a < 2; ++a)
#pragma unroll
            for (int b = 0; b < 2; ++b)
#pragma unroll
                for (int m = 0; m < 4; ++m)
#pragma unroll
                    for (int n = 0; n < 2; ++n) acc[a][b][m][n] = (f32x4){0.f, 0.f, 0.f, 0.f};
        cur = nxt; cB = nB; cA = nA; ++ui;
#pragma unroll
        for (int h = 0; h < 2; ++h)
#pragma unroll
            for (int i = 0; i < 2; ++i) voC[h][i] = voN[h][i];
        if constexpr (ALIGN_EPI) { if (wr == 1) PG8_BAR; }
    }
    PG8_WAIT_V(0);
    if constexpr (!ALIGN_EPI) { if (wr == 0) PG8_BAR; }
    PG8_BAR;
    if constexpr (Epi::AFTER_DRAIN) { E.fused(acc, cur, wr, wc, fr, fq, lds, wid, lane); }
#undef PG8_SA
#undef PG8_SB
#undef PG8_STAGE_A
#undef PG8_STAGE_B
#undef PG8_LDA
#undef PG8_LDB
#undef PG8_MMA
#undef PG8_WAIT_V
#undef PG8_WAIT_L
#undef PG8_BAR
#undef PG8_SCHED
#undef PG8_SETVO
}
}

namespace da {
constexpr int QBLK = 32, KVBLK = 64, LDQ = NQKV;
constexpr int SHM_V = KVBLK * 128 * 2, SHM_K = KVBLK * 64 * 2;
constexpr int L_V = 0, L_K = 2 * SHM_V, L_WS = L_K + 2 * SHM_K, L_TAB = L_WS + NWAVES * 64 * 4, L_STASH = L_TAB + 640 * 4, L_ENDA = L_STASH + NWAVES * 32 * 64 * 4;
static_assert(L_ENDA <= RING_BYTES && (L_STASH % 16) == 0, "attention LDS map");
constexpr float THR = 8.f;
#define SBAR() __builtin_amdgcn_sched_barrier(0)
#define KSWZ64(row, colB) ((row) * 128 + ((colB) ^ ((((row) >> 1) & 7) << 4)))
__device__ __forceinline__ int crow(int r, int hi) { return (r & 3) + 8 * (r >> 2) + 4 * hi; }

__device__ __forceinline__ float rowmax32(const f32x16& p0, const f32x16& p1) {
    float a = fmaxf(fmaxf(p0[0], p0[1]), p1[0]), b = fmaxf(fmaxf(p0[2], p0[3]), p1[1]); a = fmaxf(fmaxf(a, p1[2]), p1[3]);
#pragma unroll
    for (int r = 4; r < 16; r += 4) { a = fmaxf(fmaxf(a, p0[r]), p0[r + 1]); b = fmaxf(fmaxf(b, p0[r + 2]), p0[r + 3]); a = fmaxf(fmaxf(a, p1[r]), p1[r + 1]); b = fmaxf(fmaxf(b, p1[r + 2]), p1[r + 3]); }
    const float m = fmaxf(a, b);
    auto rr = __builtin_amdgcn_permlane32_swap(__float_as_uint(m), __float_as_uint(m), false, false);
    return fmaxf(__uint_as_float(rr[0]), __uint_as_float(rr[1]));
}
__device__ __forceinline__ void packP(const f32x16& p0, const f32x16& p1, bf16x8& pa0, bf16x8& pa1, bf16x8& pa2, bf16x8& pa3) {
#define PK4(P, BASE, OUT) do { u32x4 w = {cvt_pk_bf16(P[BASE + 0], P[BASE + 1]), cvt_pk_bf16(P[BASE + 2], P[BASE + 3]), cvt_pk_bf16(P[BASE + 4], P[BASE + 5]), cvt_pk_bf16(P[BASE + 6], P[BASE + 7])}; \
    OUT = __builtin_bit_cast(bf16x8, w); } while (0)
    PK4(p0, 0, pa0); PK4(p0, 8, pa1); PK4(p1, 0, pa2); PK4(p1, 8, pa3);
#undef PK4
}
__device__ __forceinline__ void kload8(bf16x8 (&kf)[8], const LAS char* Ks, int r32, int hi) {
#pragma unroll
    for (int d0 = 0; d0 < 4; ++d0) { const int cb = (d0 * 16 + hi * 8) * 2;
        kf[2 * d0] = *(const LAS bf16x8*)(Ks + KSWZ64(r32, cb)); kf[2 * d0 + 1] = *(const LAS bf16x8*)(Ks + KSWZ64(32 + r32, cb)); }
}
__device__ __forceinline__ void qkt_mm(f32x16& p0, f32x16& p1, const bf16x8 (&kf)[8], const bf16x8* qr, const f32x16& cinit) {
    p0 = __builtin_amdgcn_mfma_f32_32x32x16_bf16(kf[0], qr[0], cinit, 0, 0, 0); p1 = __builtin_amdgcn_mfma_f32_32x32x16_bf16(kf[1], qr[0], cinit, 0, 0, 0);
#pragma unroll
    for (int d0 = 1; d0 < 4; ++d0) { p0 = __builtin_amdgcn_mfma_f32_32x32x16_bf16(kf[2 * d0], qr[d0], p0, 0, 0, 0); p1 = __builtin_amdgcn_mfma_f32_32x32x16_bf16(kf[2 * d0 + 1], qr[d0], p1, 0, 0, 0); }
}
__device__ __forceinline__ void qkt(f32x16& p0, f32x16& p1, const LAS char* Ks, const bf16x8* qr, const f32x16& cinit, int r32, int hi) {
    bf16x8 kf[8]; kload8(kf, Ks, r32, hi);
    asm volatile("s_waitcnt lgkmcnt(0)" ::: "memory"); SBAR();
    qkt_mm(p0, p1, kf, qr, cinit);
}
__device__ __forceinline__ int v_st(int k, int c) { const int kk = (k & ~0xC) | ((k & 4) << 1) | ((k & 8) >> 1); return ((kk >> 3) * 4 + (c >> 5)) * 512 + ((kk & 7) * 32 + (c & 31)) * 2; }
__device__ __forceinline__ int v_rd_base(int lane) { return ((lane & 3) << 3) | (((lane >> 2) & 3) << 6) | (((lane >> 4) & 1) << 5) | (((lane >> 5) & 1) << 8); }
constexpr int v_rd_off(int d0, int ks, int half) { return d0 * 512 + ks * 4096 + half * 2048; }
template <int OFF> __device__ __forceinline__ s16x4 tr_read(int vb) {
    s16x4 r; asm volatile("ds_read_b64_tr_b16 %0, %1 offset:%2" : "=&v"(r) : "v"(vb), "i"(OFF) : "memory"); return r;
}
template <int D0> __device__ __forceinline__ void pv_one(f32x16& od, int vb, bf16x8 pa0, bf16x8 pa1, bf16x8 pa2, bf16x8 pa3) {
#define PK(L, H) (bf16x8){L[0], L[1], L[2], L[3], H[0], H[1], H[2], H[3]}
    { const s16x4 l0 = tr_read<v_rd_off(D0, 0, 0)>(vb), h0 = tr_read<v_rd_off(D0, 0, 1)>(vb), l1 = tr_read<v_rd_off(D0, 1, 0)>(vb), h1 = tr_read<v_rd_off(D0, 1, 1)>(vb);
      asm volatile("s_waitcnt lgkmcnt(0)" ::: "memory"); SBAR();
      od = __builtin_amdgcn_mfma_f32_32x32x16_bf16(pa0, PK(l0, h0), od, 0, 0, 0);
      od = __builtin_amdgcn_mfma_f32_32x32x16_bf16(pa1, PK(l1, h1), od, 0, 0, 0); }
    { const s16x4 l2 = tr_read<v_rd_off(D0, 2, 0)>(vb), h2 = tr_read<v_rd_off(D0, 2, 1)>(vb), l3 = tr_read<v_rd_off(D0, 3, 0)>(vb), h3 = tr_read<v_rd_off(D0, 3, 1)>(vb);
      asm volatile("s_waitcnt lgkmcnt(0)" ::: "memory"); SBAR();
      od = __builtin_amdgcn_mfma_f32_32x32x16_bf16(pa2, PK(l2, h2), od, 0, 0, 0);
      od = __builtin_amdgcn_mfma_f32_32x32x16_bf16(pa3, PK(l3, h3), od, 0, 0, 0); }
#undef PK
}
__device__ __forceinline__ void pv_d0(f32x16* o, int vb, bf16x8 pa0, bf16x8 pa1, bf16x8 pa2, bf16x8 pa3) {
    pv_one<0>(o[0], vb, pa0, pa1, pa2, pa3); pv_one<1>(o[1], vb, pa0, pa1, pa2, pa3); pv_one<2>(o[2], vb, pa0, pa1, pa2, pa3); pv_one<3>(o[3], vb, pa0, pa1, pa2, pa3);
}
__device__ __forceinline__ void biasmask(f32x16& p0, f32x16& p1, int base, int hi, const LAS float* tab) {
    const LAS float* tp = tab + (base + 256 - 4 * hi - 59);
    const int bl = base - 4 * hi;
#pragma unroll
    for (int q = 0; q < 4; ++q) {
        float b0[4], b1[4];
#pragma unroll
        for (int i = 0; i < 4; ++i) { b0[i] = tp[59 - (i + 8 * q)]; b1[i] = tp[59 - 32 - (i + 8 * q)]; }
        asm volatile("s_waitcnt lgkmcnt(0)" ::: "memory"); SBAR();
#pragma unroll
        for (int i = 0; i < 4; ++i) { const int kk = i + 8 * q, r = 4 * q + i;
            const float a0 = p0[r] + b0[i], a1 = p1[r] + b1[i];
            p0[r] = (kk > bl) ? -INFINITY : a0;
            p1[r] = (kk + 32 > bl) ? -INFINITY : a1; }
        SBAR();
    }
}

__device__ __forceinline__ void flash_pass(f32x16 (&o)[4], const bf16* __restrict__ Qw, const bf16* __restrict__ Kh, const bf16* __restrict__ Vh,
                                           int NT, int qabs, lds_u8* lds, int wv) {
    const int tid = tid_opaque(wv), wid = wv, lane = tid & 63, r32 = lane & 31, hi = lane >> 5;
    LAS char* V_lds = (LAS char*)(lds + L_V); LAS char* K_lds = (LAS char*)(lds + L_K);
    LAS float* al_l = (LAS float*)(lds + L_WS) + wid * 64;
    const LAS float* tab = (const LAS float*)(lds + L_TAB);
    unsigned koff, voff0, voff1;
    { const int g = wid * 64 + lane, row = g >> 3; koff = (unsigned)(row * LDQ + (((g & 7) ^ ((row >> 1) & 7)) * 8)) * 2u; }
    { const int g = (wid * 2) * 64 + lane, st = g >> 5, k = ((st >> 2) << 3) | ((g >> 2) & 7), c = (st & 3) * 32 + (g & 3) * 8; voff0 = (unsigned)(k * LDQ + c) * 2u; }
    { const int g = (wid * 2 + 1) * 64 + lane, st = g >> 5, k = ((st >> 2) << 3) | ((g >> 2) & 7), c = (st & 3) * 32 + (g & 3) * 8; voff1 = (unsigned)(k * LDQ + c) * 2u; }
#define GLDS16(src, dst) __builtin_amdgcn_global_load_lds((const unsigned*)(src), (LAS unsigned*)(dst), 16, 0, 0)
#define DMA_K(t, slot) GLDS16((const char*)Kh + (size_t)(t) * (KVBLK * LDQ * 2) + koff, K_lds + (slot) * SHM_K + wid * 1024)
#define DMA_V(t, slot) do { const char* vt_ = (const char*)Vh + (size_t)(t) * (KVBLK * LDQ * 2); \
    GLDS16(vt_ + voff0, V_lds + (slot) * SHM_V + wid * 2048); GLDS16(vt_ + voff1, V_lds + (slot) * SHM_V + wid * 2048 + 1024); } while (0)
#define WAIT_BAR() asm volatile("s_waitcnt vmcnt(0) lgkmcnt(0)\n\ts_barrier" ::: "memory")
    DMA_K(0, 0); DMA_V(0, 0); DMA_K(1, 1);
    bf16x8 qr[4];
#pragma unroll
    for (int d0 = 0; d0 < 4; ++d0) { o[d0] = f32x16{}; qr[d0] = *(const bf16x8*)(Qw + d0 * 16); }
    float z0_ = 0.f; asm volatile("" : "+v"(z0_));
    f32x16 negm, lacc = f32x16{};
#pragma unroll
    for (int r = 0; r < 16; ++r) negm[r] = z0_;
    asm volatile("" : "+v"(negm));
    float mhat = 0.f;
    const u32x4 onesw = {0x3F803F80u, 0x3F803F80u, 0x3F803F80u, 0x3F803F80u}; const bf16x8 ones = __builtin_bit_cast(bf16x8, onesw);
    const int vb0 = (int)(uintptr_t)V_lds + v_rd_base(lane);
    const int jlast = NT - 4 + (wid >> 1);
    f32x16 pA0, pA1, pB0, pB1; bf16x8 pa0, pa1, pa2, pa3; bool resc = false;
#define BMASK(P0, P1, j) do { if ((j) >= jlast - 2) biasmask(P0, P1, qabs - 64 * (j), hi, tab); } while (0)
#define DECIDE_A(C0, C1, FIRST) do { const float rm = rowmax32(C0, C1); resc = false; \
    if ((FIRST) || __any(rm > THR)) { const float dl = (FIRST) ? rm : fmaxf(rm, 0.f); mhat += dl; \
        _Pragma("unroll") for (int r = 0; r < 16; ++r) { C0[r] -= dl; C1[r] -= dl; } \
        _Pragma("unroll") for (int r = 0; r < 16; ++r) negm[r] = -mhat; asm volatile("" : "+v"(negm)); \
        if (!(FIRST)) { const float f = __builtin_amdgcn_exp2f(-dl); if (hi == 0) al_l[r32] = f; resc = true; } } } while (0)
#define EXPALL(C0, C1) do { _Pragma("unroll") for (int r = 0; r < 16; ++r) { C0[r] = __builtin_amdgcn_exp2f(C0[r]); C1[r] = __builtin_amdgcn_exp2f(C1[r]); } } while (0)
#define RESC() do { if (resc) { asm volatile("s_waitcnt lgkmcnt(0)" ::: "memory"); \
    _Pragma("unroll") for (int r = 0; r < 16; ++r) { const float f = al_l[crow(r, hi)]; o[0][r] *= f; o[1][r] *= f; o[2][r] *= f; o[3][r] *= f; lacc[r] *= f; } resc = false; } } while (0)
#define LSUM() do { lacc = __builtin_amdgcn_mfma_f32_32x32x16_bf16(pa0, ones, lacc, 0, 0, 0); lacc = __builtin_amdgcn_mfma_f32_32x32x16_bf16(pa1, ones, lacc, 0, 0, 0); \
    lacc = __builtin_amdgcn_mfma_f32_32x32x16_bf16(pa2, ones, lacc, 0, 0, 0); lacc = __builtin_amdgcn_mfma_f32_32x32x16_bf16(pa3, ones, lacc, 0, 0, 0); } while (0)
#define MF32(a, b, c) __builtin_amdgcn_mfma_f32_32x32x16_bf16(a, b, c, 0, 0, 0)
#define PKV(L, H) (bf16x8){L[0], L[1], L[2], L[3], H[0], H[1], H[2], H[3]}
#define RD(G) const s16x4 la##G = tr_read<v_rd_off((G) >> 1, 2 * ((G) & 1), 0)>(vb_), ha##G = tr_read<v_rd_off((G) >> 1, 2 * ((G) & 1), 1)>(vb_), \
                          lb##G = tr_read<v_rd_off((G) >> 1, 2 * ((G) & 1) + 1, 0)>(vb_), hb##G = tr_read<v_rd_off((G) >> 1, 2 * ((G) & 1) + 1, 1)>(vb_)
#define MM(G, PA, PB) asm volatile("s_waitcnt lgkmcnt(0)" ::: "memory"); SBAR(); \
    o[(G) >> 1] = MF32(PA, PKV(la##G, ha##G), o[(G) >> 1]); o[(G) >> 1] = MF32(PB, PKV(lb##G, hb##G), o[(G) >> 1])
#define EX4(C, B) C[B] = __builtin_amdgcn_exp2f(C[B]); C[B + 1] = __builtin_amdgcn_exp2f(C[B + 1]); C[B + 2] = __builtin_amdgcn_exp2f(C[B + 2]); C[B + 3] = __builtin_amdgcn_exp2f(C[B + 3]); \
    asm volatile("" : "+v"(C)); SBAR()
#define STEP(Cn0, Cn1, Pp0, Pp1, s, KS, VS) do { SBAR(); \
    bf16x8 kf_[8]; kload8(kf_, K_lds + (KS) * SHM_K, r32, hi); SBAR();        \
    packP(Pp0, Pp1, pa0, pa1, pa2, pa3); SBAR(); \
    asm volatile("s_waitcnt lgkmcnt(0)" ::: "memory"); SBAR(); qkt_mm(Cn0, Cn1, kf_, qr, negm); SBAR(); \
    const int vb_ = vb0 + (VS) * SHM_V; \
    RD(0); SBAR(); \
    BMASK(Cn0, Cn1, s); DECIDE_A(Cn0, Cn1, false); SBAR(); \
    MM(0, pa0, pa1); RD(1); EX4(Cn0, 0); \
    MM(1, pa2, pa3); RD(2); EX4(Cn0, 4); \
    MM(2, pa0, pa1); RD(3); EX4(Cn0, 8); \
    MM(3, pa2, pa3); RD(4); EX4(Cn0, 12); \
    MM(4, pa0, pa1); RD(5); EX4(Cn1, 0); \
    MM(5, pa2, pa3); RD(6); EX4(Cn1, 4); \
    MM(6, pa0, pa1); RD(7); EX4(Cn1, 8); \
    MM(7, pa2, pa3);        EX4(Cn1, 12); \
    LSUM(); \
    WAIT_BAR(); \
    if ((s) + 2 < NT) DMA_K((s) + 2, KS); if ((s) + 1 < NT) DMA_V((s) + 1, VS); \
    RESC(); } while (0)
    WAIT_BAR();
    qkt(pA0, pA1, K_lds, qr, negm, r32, hi); BMASK(pA0, pA1, 0); DECIDE_A(pA0, pA1, true); EXPALL(pA0, pA1);
    WAIT_BAR();
    DMA_K(2, 0); DMA_V(1, 1);
    const int jl2 = jlast | 1;
    STEP(pB0, pB1, pA0, pA1, 1, 1, 0);
    int s = 2;
    for (; s < jl2; s += 2) {
        STEP(pA0, pA1, pB0, pB1, s, 0, 1);
        STEP(pB0, pB1, pA0, pA1, s + 1, 1, 0);
    }
    packP(pB0, pB1, pa0, pa1, pa2, pa3); pv_d0(o, vb0 + SHM_V, pa0, pa1, pa2, pa3); LSUM();
    for (; s < NT; ++s) { WAIT_BAR(); if (s + 2 < NT) DMA_K(s + 2, s & 1); if (s + 1 < NT) DMA_V(s + 1, (s + 1) & 1); }
#pragma unroll
    for (int r = 0; r < 16; ++r) { const float rl = __builtin_amdgcn_rcpf(lacc[r]);
#pragma unroll
        for (int d = 0; d < 4; ++d) o[d][r] *= rl; }
    WAIT_BAR();
#undef GLDS16
#undef DMA_K
#undef DMA_V
#undef WAIT_BAR
#undef BMASK
#undef DECIDE_A
#undef EXPALL
#undef MF32
#undef PKV
#undef RD
#undef MM
#undef EX4
#undef RESC
#undef STEP
#undef LSUM
}

__device__ __forceinline__ void attn_unit(int b, int h, int qt, const bf16* qkv, bf16* ob, const float* dtab, const float* subg, float lam, lds_u8* lds, int wv) {
    const int tid = tid_opaque(wv), wid = tid >> 6, lane = tid & 63, r32 = lane & 31, hi = lane >> 5;
    LAS float* tab = (LAS float*)(lds + L_TAB);
    for (int i = tid; i < 640; i += NTHREADS) { const int d = i - 256; tab[i] = (d >= 0 && d < 128) ? dtab[h * 128 + d] : 0.f; }
    __syncthreads();
    const long rowbase = (long)b * SEQ; const int q0 = qt * 256; const int NT = 4 * qt + 4;
    const int qabs = q0 + wid * QBLK + r32;
    LAS unsigned* stash = (LAS unsigned*)(lds + L_STASH) + wid * (32 * 64) + lane;
    f32x16 o[4];
    { const bf16* Qw = qkv + (rowbase + qabs) * LDQ + h * 128 + hi * 8;
      const bf16* Kh = qkv + rowbase * LDQ + 1024 + h * 128;
      const bf16* Vh = qkv + rowbase * LDQ + 2048 + h * 128;
      flash_pass(o, Qw, Kh, Vh, NT, qabs, lds, wv);
#pragma unroll
      for (int r = 0; r < 16; ++r) { stash[(2 * r) * 64] = cvt_pk_bf16(o[0][r], o[1][r]); stash[(2 * r + 1) * 64] = cvt_pk_bf16(o[2][r], o[3][r]); } }
    { const bf16* Qw = qkv + (rowbase + qabs) * LDQ + h * 128 + 64 + hi * 8;
      const bf16* Kh = qkv + rowbase * LDQ + 1024 + h * 128 + 64;
      const bf16* Vh = qkv + rowbase * LDQ + 2048 + h * 128;
      flash_pass(o, Qw, Kh, Vh, NT, qabs, lds, wv); }
    LDS_WAIT();
    unsigned sw[32];
#pragma unroll
    for (int i = 0; i < 32; ++i) sw[i] = stash[i * 64];
    float gsc[4];
#pragma unroll
    for (int d = 0; d < 4; ++d) gsc[d] = subg[32 * d + r32] * 0.8f;
    LDS_WAIT();
    LAS bf16* stg = (LAS bf16*)((LAS unsigned*)(lds + L_STASH) + wid * (32 * 64));
#pragma unroll
    for (int r = 0; r < 16; ++r) {
        const unsigned w0 = sw[2 * r], w1 = sw[2 * r + 1];
        const float v0 = bf_lo(w0) - lam * o[0][r], v1 = bf_hi(w0) - lam * o[1][r], v2 = bf_lo(w1) - lam * o[2][r], v3 = bf_hi(w1) - lam * o[3][r];
        float ss = (v0 * v0 + v1 * v1) + (v2 * v2 + v3 * v3);
        ss += __shfl_xor(ss, 1); ss += __shfl_xor(ss, 2); ss += __shfl_xor(ss, 4); ss += __shfl_xor(ss, 8); ss += __shfl_xor(ss, 16);
        const float rs = 1.0f / sqrtf(ss * (1.0f / 128.0f) + LN_EPS);
        LAS bf16* sp = stg + crow(r, hi) * 128 + r32;
        sp[0] = (bf16)(cvt_pk_bf16(v0 * rs * gsc[0], 0.f) & 0xffffu); sp[32] = (bf16)(cvt_pk_bf16(v1 * rs * gsc[1], 0.f) & 0xffffu);
        sp[64] = (bf16)(cvt_pk_bf16(v2 * rs * gsc[2], 0.f) & 0xffffu); sp[96] = (bf16)(cvt_pk_bf16(v3 * rs * gsc[3], 0.f) & 0xffffu);
    }
    LDS_WAIT();
    { bf16* obase = ob + (rowbase + q0 + wid * QBLK) * D + h * 128;
#pragma unroll
      for (int i = 0; i < 8; ++i) { const int row = i * 4 + (lane >> 4), ch = lane & 15;
          const u32x4 v = *(const LAS u32x4*)(stg + row * 128 + ch * 8); *(u32x4*)(obase + (size_t)row * D + ch * 8) = v; } }
    __syncthreads();
}
}

namespace sg {
constexpr int L_VT = 0;
constexpr int L_ST = 65536;
constexpr int L_STG = 66560;
constexpr int STG_LD = 68, STG_BYTES = 32 * STG_LD * 4;
constexpr int L_PRM = L_STG + NWAVES * STG_BYTES;
static_assert(L_PRM + 2048 <= LDSCTL_OFF, "spatial LDS map");
__device__ __forceinline__ void chunk_unit(int ch, bf16* U, const bf16* V, const f32x2* vstat, const float* lng, const float* lnb, const bf16* wtril, const float* bs, lds_u8* lds, int wv) {
    const int tid = tid_opaque(wv), wid = tid >> 6, lane = tid & 63, r32 = lane & 31, hi = lane >> 5;
    const long R0 = (long)ch * SGC;
    LAS float* st = (LAS float*)(lds + L_ST);
    if (tid < SGC) { const f32x2* sp = vstat + (size_t)(R0 + tid) * 48; float s_ = 0.f, q_ = 0.f;
#pragma unroll 8
        for (int i = 0; i < 48; ++i) { const f32x2 t = sp[i]; s_ += t.x; q_ += t.y; }
        const float mu = s_ * (1.0f / SGH); const float var = fmaxf(q_ * (1.0f / SGH) - mu * mu, 0.f);
        st[tid * 2] = mu; st[tid * 2 + 1] = 1.0f / sqrtf(var + LN_EPS); }
    __syncthreads();
    const int sr = tid >> 4, sc = (tid & 15) * 8;
    const int rb = wid & 3, chh = wid >> 2;
    LAS float* stg = (LAS float*)(lds + L_STG + wid * STG_BYTES);
    u32x4 vq[4]; f32x4 pq = {0.f, 0.f, 0.f, 0.f};
#define SG_LOADV(SL) do { const int c0_ = (SL) * 128; \
    _Pragma("unroll") for (int i = 0; i < 4; ++i) { const bf16* p_ = V + (R0 + sr + 32 * i) * SGH + c0_ + sc; GLOAD16(vq[i], p_, 0); } } while (0)
#define SG_LOADP(SL) do { if (wid == 0) { const float* pp_ = (lane < 32 ? lng : lnb) + (SL) * 128 + 4 * (lane & 31); GLOAD16(pq, pp_, 0); } } while (0)
#define SG_PUTP(SL) do { if (wid == 0) { *(LAS f32x4*)(lds + L_PRM + ((SL) & 1) * 1024 + (lane >> 5) * 512 + (lane & 31) * 16) = pq; } } while (0)
    bf16x8 wfn[8]; u32x4 uqn[4]; float btn[4];
#define SG_LOADU(SL) do { const int g_ = (SL) / 3, c0_ = (SL) * 128; const bf16* wrow_ = wtril + ((size_t)g_ * 128 + rb * 32 + r32) * 128 + hi * 8; \
    if ((SL) % 3 == 0) { GLOAD16(wfn[0], wrow_, 0); GLOAD16(wfn[1], wrow_, 32); GLOAD16(wfn[2], wrow_, 64); GLOAD16(wfn[3], wrow_, 96); \
      if (rb >= 2) { GLOAD16(wfn[4], wrow_, 128); GLOAD16(wfn[5], wrow_, 160); GLOAD16(wfn[6], wrow_, 192); GLOAD16(wfn[7], wrow_, 224); } }     \
    _Pragma("unroll") for (int i = 0; i < 4; ++i) { const int tr_ = (lane >> 3) + 8 * i, cc_ = (lane & 7) * 8; const int t_ = rb * 32 + tr_; \
        const bf16* pu_ = U + (R0 + t_) * SGH + c0_ + chh * 64 + cc_; const float* pbs_ = bs + g_ * 128 + t_; GLOAD16(uqn[i], pu_, 0); if ((SL) % 3 == 0) GLOAD4(btn[i], pbs_, 0); } } while (0)
#define SG_WAIT(N) do { asm volatile("s_waitcnt vmcnt(" #N ")" : "+v"(vq[0]), "+v"(vq[1]), "+v"(vq[2]), "+v"(vq[3]), "+v"(pq) :: "memory"); \
    asm volatile("" : "+v"(wfn[0]), "+v"(wfn[1]), "+v"(wfn[2]), "+v"(wfn[3]), "+v"(uqn[0]), "+v"(uqn[1]), "+v"(uqn[2]), "+v"(uqn[3]) :: "memory"); \
    asm volatile("" : "+v"(btn[0]), "+v"(btn[1]), "+v"(btn[2]), "+v"(btn[3]) :: "memory"); \
    if (rb >= 2) asm volatile("" : "+v"(wfn[4]), "+v"(wfn[5]), "+v"(wfn[6]), "+v"(wfn[7]) :: "memory"); } while (0)
    bf16x8 wf[8]; float btq[4];
    float rsr[4], shr[4];
#pragma unroll
    for (int i = 0; i < 4; ++i) { const int row = sr + 32 * i; rsr[i] = st[row * 2 + 1]; shr[i] = -st[row * 2] * rsr[i]; }
    SG_LOADP(0); SG_WAIT(0); SG_PUTP(0); SG_LOADP(1); SG_WAIT(0); SG_PUTP(1);
    SG_LOADV(0); SG_LOADU(0); SG_WAIT(0);
    LDS_WAIT(); __syncthreads();
#pragma unroll 1
    for (int sl = 0; sl < 24; ++sl) {
        const int c0 = sl * 128; const int buf = sl & 1;
        LAS char* vt = (LAS char*)(lds + L_VT + buf * 32768);
        const LAS float* prm = (const LAS float*)(lds + L_PRM + buf * 1024);
        const f32x4 ga = *(const LAS f32x4*)(prm + sc), gb = *(const LAS f32x4*)(prm + sc + 4), ba = *(const LAS f32x4*)(prm + 128 + sc), bb = *(const LAS f32x4*)(prm + 128 + sc + 4);
#pragma unroll
        for (int i = 0; i < 4; ++i) { const int row = sr + 32 * i; const u32x4 w = vq[i];
            const float rs = rsr[i], sh = shr[i];
            u32x4 o;
#define NRM(X, G, B) (((X) * rs + sh) * (G) + (B))
            o.x = cvt_pk_bf16(NRM(bf_lo(w.x), ga[0], ba[0]), NRM(bf_hi(w.x), ga[1], ba[1]));
            o.y = cvt_pk_bf16(NRM(bf_lo(w.y), ga[2], ba[2]), NRM(bf_hi(w.y), ga[3], ba[3]));
            o.z = cvt_pk_bf16(NRM(bf_lo(w.z), gb[0], bb[0]), NRM(bf_hi(w.z), gb[1], bb[1]));
            o.w = cvt_pk_bf16(NRM(bf_lo(w.w), gb[2], bb[2]), NRM(bf_hi(w.w), gb[3], bb[3]));
#undef NRM
            *(LAS u32x4*)(vt + (row >> 6) * 16384 + da::v_st(row & 63, sc)) = o; }
        u32x4 uq[4];
        if (sl % 3 == 0) {
#pragma unroll
            for (int j = 0; j < 8; ++j) wf[j] = wfn[j];
#pragma unroll
            for (int i = 0; i < 4; ++i) btq[i] = btn[i]; }
#pragma unroll
        for (int i = 0; i < 4; ++i) uq[i] = uqn[i];
        { const int sn = sl + 1 < 24 ? sl + 1 : 23, sp = sl + 2 < 24 ? sl + 2 : 23; SG_LOADV(sn); SG_LOADU(sn); SG_LOADP(sp); }
        __syncthreads();
        f32x16 o0 = f32x16{}, o1 = f32x16{};
        const int vb = (int)(uintptr_t)vt + da::v_rd_base(lane);
        if (chh == 0) { da::pv_one<0>(o0, vb, wf[0], wf[1], wf[2], wf[3]); da::pv_one<1>(o1, vb, wf[0], wf[1], wf[2], wf[3]); }
        else          { da::pv_one<2>(o0, vb, wf[0], wf[1], wf[2], wf[3]); da::pv_one<3>(o1, vb, wf[0], wf[1], wf[2], wf[3]); }
        if (rb >= 2) {
            if (chh == 0) { da::pv_one<0>(o0, vb + 16384, wf[4], wf[5], wf[6], wf[7]); da::pv_one<1>(o1, vb + 16384, wf[4], wf[5], wf[6], wf[7]); }
            else          { da::pv_one<2>(o0, vb + 16384, wf[4], wf[5], wf[6], wf[7]); da::pv_one<3>(o1, vb + 16384, wf[4], wf[5], wf[6], wf[7]); } }
#pragma unroll
        for (int r = 0; r < 16; ++r) { const int tr = da::crow(r, hi); stg[tr * STG_LD + r32] = o0[r]; stg[tr * STG_LD + 32 + r32] = o1[r]; }
        LDS_WAIT();
#pragma unroll
        for (int i = 0; i < 4; ++i) { const int tr = (lane >> 3) + 8 * i, cc = (lane & 7) * 8; const int t = rb * 32 + tr; const float bt = btq[i];
            const f32x4 s0 = *(const LAS f32x4*)(stg + tr * STG_LD + cc), s1 = *(const LAS f32x4*)(stg + tr * STG_LD + cc + 4);
            bf16* up = U + (R0 + t) * SGH + c0 + chh * 64 + cc; const u32x4 uw = uq[i]; u32x4 ow;
            { const f32x2 g0 = gelu_tanh2((f32x2){bf_lo(uw.x), bf_hi(uw.x)}), g1 = gelu_tanh2((f32x2){bf_lo(uw.y), bf_hi(uw.y)}), g2 = gelu_tanh2((f32x2){bf_lo(uw.z), bf_hi(uw.z)}), g3 = gelu_tanh2((f32x2){bf_lo(uw.w), bf_hi(uw.w)});
              ow.x = cvt_pk_bf16(g0.x * (s0[0] + bt), g0.y * (s0[1] + bt)); ow.y = cvt_pk_bf16(g1.x * (s0[2] + bt), g1.y * (s0[3] + bt));
              ow.z = cvt_pk_bf16(g2.x * (s1[0] + bt), g2.y * (s1[1] + bt)); ow.w = cvt_pk_bf16(g3.x * (s1[2] + bt), g3.y * (s1[3] + bt)); }
            *(u32x4*)up = ow; }
        LDS_WAIT();
        SG_WAIT(4);
        SG_PUTP(sl);
    }
#undef SG_WAIT
#undef SG_LOADP
#undef SG_PUTP
#undef SG_LOADV
#undef SG_LOADU
    __syncthreads();
}
}

#define XB_TMO      128
#define XB_XCNT(j)  (256  + 64 * (j))
#define XB_XSUB(j)  (1280 + 64 * (j))
#define XB_XGEN(j)  (2304 + 64 * (j))
#define XB_TOP      3328
#define XB_TOPGEN   3392
#define XCD_BAR_WORDS 3456
#define XB_SPIN_CAP (1u << 22)
__device__ __forceinline__ unsigned xb_ld(unsigned* p)              { return __hip_atomic_load(p, __ATOMIC_RELAXED, __HIP_MEMORY_SCOPE_AGENT); }
__device__ __forceinline__ unsigned xb_add(unsigned* p, unsigned v) { return __hip_atomic_fetch_add(p, v, __ATOMIC_RELAXED, __HIP_MEMORY_SCOPE_AGENT); }
__device__ __forceinline__ unsigned xb_xcc_id() { return (unsigned)__builtin_amdgcn_s_getreg((3 << 11) | 20) & 0xFu; }
#define XB_SPIN(cond, bar) do { unsigned _sp = 0; while (cond) { __builtin_amdgcn_s_sleep(1); \
    if ((++_sp & 255u) == 0u) { if (xb_ld(&(bar)[XB_TMO])) break; if (_sp > XB_SPIN_CAP) { atomicAdd(&(bar)[XB_TMO], 1u); break; } } } } while (0)
struct XcdBarrier { unsigned* bar; unsigned x; volatile LAS unsigned* st; int wv; };
__device__ __forceinline__ XcdBarrier xcd_barrier_post(unsigned* bar, volatile LAS unsigned* st, int wv) {
    XcdBarrier b; b.bar = bar; b.x = xb_xcc_id(); b.st = st; b.wv = wv;
    if (wv == 0 && lane_id() == 0) (void)xb_add(&bar[XB_XCNT(b.x)], 1u);
    return b;
}
__device__ __forceinline__ void xcd_barrier_complete(unsigned* bar, unsigned x, unsigned& nloc, unsigned& nx) {
    const unsigned G = gridDim.x * gridDim.y * gridDim.z;
    unsigned sum, cnt, mine, sp = 0u;
    for (;;) {
        sum = 0u; cnt = 0u; mine = 0u;
#pragma unroll
        for (unsigned j = 0; j < 16; ++j) { const unsigned c = xb_ld(&bar[XB_XCNT(j)]); sum += c; cnt += (c > 0u) ? 1u : 0u; mine = (j == x) ? c : mine; }
        if (sum == G) break;
        __builtin_amdgcn_s_sleep(1);
        if ((++sp & 255u) == 0u) { if (xb_ld(&bar[XB_TMO])) break; if (sp > XB_SPIN_CAP) { atomicAdd(&bar[XB_TMO], 1u); break; } }
    }
    nloc = mine > 0u ? mine : 1u; nx = cnt > 0u ? cnt : 1u;
}
__device__ __forceinline__ void xcd_barrier(const XcdBarrier& b) {
    asm volatile("s_waitcnt vmcnt(0)" ::: "memory");
    __syncthreads();
    int l0_ = lane_id(); asm volatile("" : "+v"(l0_));
    if (b.wv == 0 && l0_ == 0) {
        unsigned* bar = b.bar; unsigned bx_ = __builtin_amdgcn_readfirstlane(b.x);
        asm volatile("" : "+s"(bar), "+s"(bx_));
        __builtin_amdgcn_s_waitcnt(0);
        unsigned nloc = b.st[0], nx = b.st[1];
        if (nloc == 0u) { xcd_barrier_complete(bar, bx_, nloc, nx); b.st[0] = nloc; b.st[1] = nx; }
        const unsigned old = xb_add(&bar[XB_XSUB(bx_)], 1u);
        const unsigned gen = old / nloc;
        if (old + 1u == (gen + 1u) * nloc) {
            __builtin_amdgcn_fence(__ATOMIC_RELEASE, "agent");
            asm volatile("s_waitcnt vmcnt(0)" ::: "memory");
            const unsigned og = xb_add(&bar[XB_TOP], 1u);
            const unsigned tg = og / nx;
            if (og + 1u == (tg + 1u) * nx) xb_add(&bar[XB_TOPGEN], 1u);
            else XB_SPIN(xb_ld(&bar[XB_TOPGEN]) == tg, bar);
            __builtin_amdgcn_fence(__ATOMIC_ACQUIRE, "agent");
            xb_add(&bar[XB_XGEN(bx_)], 1u);
            asm volatile("s_waitcnt vmcnt(0)" ::: "memory");
        } else {
            XB_SPIN(xb_ld(&bar[XB_XGEN(bx_)]) == gen, bar);
            __builtin_amdgcn_fence(__ATOMIC_ACQUIRE, "agent");
            asm volatile("s_waitcnt vmcnt(0)" ::: "memory");
        }
    }
    __syncthreads();
}

struct TItem { const float* src; int N; bf16* dst; int ldk; };
__device__ __forceinline__ void titem_load(const TItem& t, f32x4 (&v)[8], int lane) {
    const float* src = t.src + (size_t)(lane >> 3) * t.N + (lane & 7) * 4;
#pragma unroll
    for (int i = 0; i < 8; ++i) v[i] = __builtin_nontemporal_load((const f32x4*)(src + (size_t)(8 * i) * t.N));
}
__device__ __forceinline__ void titem_store(const TItem& t, const f32x4 (&v)[8], LAS float* scr, int lane) {
#pragma unroll
    for (int i = 0; i < 8; ++i) { LAS float* d = scr + (8 * i + (lane >> 3)) * 33 + (lane & 7) * 4; d[0] = v[i].x; d[1] = v[i].y; d[2] = v[i].z; d[3] = v[i].w; }
    LDS_WAIT(); asm volatile("" ::: "memory");
    const int c = lane & 7;
#pragma unroll
    for (int j = 0; j < 4; ++j) { const int n = (lane >> 3) + 8 * j; const LAS float* s = scr + (8 * c) * 33 + n;
        u32x4 o; o.x = cvt_pk_bf16(s[0 * 33], s[1 * 33]); o.y = cvt_pk_bf16(s[2 * 33], s[3 * 33]); o.z = cvt_pk_bf16(s[4 * 33], s[5 * 33]); o.w = cvt_pk_bf16(s[6 * 33], s[7 * 33]);
        *(u32x4*)(t.dst + (size_t)n * t.ldk + 8 * c) = o; }
    LDS_WAIT(); asm volatile("" ::: "memory");
}
__device__ __forceinline__ TItem plain_item(const float* W, int K, int N, bf16* WT, int it) {
    const int nblk = N / 32, kb = it / nblk, nb = it % nblk;
    return TItem{W + (size_t)(64 * kb) * N + 32 * nb, N, WT + (size_t)(32 * nb) * K + 64 * kb, K};
}
__device__ __forceinline__ void transpose_matrix(const float* W, int K, int N, bf16* WT, LAS float* scr, int gw, int ngw, int lane) {
    const int nitems = (K / 64) * (N / 32);
    int it = gw; if (it >= nitems) return;
    f32x4 v[8], vn[8]; TItem t = plain_item(W, K, N, WT, it); titem_load(t, vn, lane);
    for (; it < nitems; it += ngw) {
#pragma unroll
        for (int i = 0; i < 8; ++i) v[i] = vn[i];
        const TItem tc = t;
        if (it + ngw < nitems) { t = plain_item(W, K, N, WT, it + ngw); titem_load(t, vn, lane); }
        titem_store(tc, v, scr, lane);
    }
}
__device__ __forceinline__ TItem moe_item(const float* wg, const float* wu, const float* wd, bf16* B1, bf16* B2, int it) {
    constexpr int IPE = 3 * 256;
    const int e = it / IPE, r = it % IPE, m = r >> 8, q = r & 255;
    if (m < 2) { const int kb = q >> 4, nb = q & 15; const int n0 = 32 * nb;
        const float* W = (m == 0 ? wg : wu) + (size_t)e * D * MOEH;
        const int row_off = (n0 >> 7) * 256 + m * 128 + (n0 & 127);
        return TItem{W + (size_t)(64 * kb) * MOEH + n0, MOEH, B1 + (size_t)e * D * D + (size_t)row_off * D + 64 * kb, D}; }
    const int kb = q >> 5, nb = q & 31;
    return TItem{wd + (size_t)e * MOEH * D + (size_t)(64 * kb) * D + 32 * nb, D, B2 + (size_t)e * D * MOEH + (size_t)(32 * nb) * MOEH + 64 * kb, MOEH};
}
__device__ __forceinline__ void convert_moe(const float* wg, const float* wu, const float* wd, bf16* B1, bf16* B2, LAS float* scr, int gw, int ngw, int lane) {
    constexpr int NIT = NEXP * 3 * 256;
    int it = gw; if (it >= NIT) return;
    f32x4 v[8], vn[8]; TItem t = moe_item(wg, wu, wd, B1, B2, it); titem_load(t, vn, lane);
    for (; it < NIT; it += ngw) {
#pragma unroll
        for (int i = 0; i < 8; ++i) v[i] = vn[i];
        const TItem tc = t;
        if (it + ngw < NIT) { t = moe_item(wg, wu, wd, B1, B2, it + ngw); titem_load(t, vn, lane); }
        titem_store(tc, v, scr, lane);
    }
}
__device__ __forceinline__ int t5_bucket(int n) {
    if (n < 16) return n;
    int large = 16 + (int)(logf((float)n / 16.0f) / logf(8.0f) * 16.0f);
    return large < 31 ? large : 31;
}

__device__ __forceinline__ void ln_params(const float* g, const float* b, float (&gr)[16], float (&br)[16], int lane) {
#pragma unroll
    for (int j = 0; j < 2; ++j) { const int c = 8 * lane + 512 * j;
        const f32x4 g0 = *(const f32x4*)(g + c), g1 = *(const f32x4*)(g + c + 4), b0 = *(const f32x4*)(b + c), b1 = *(const f32x4*)(b + c + 4);
#pragma unroll
        for (int k = 0; k < 4; ++k) { gr[8 * j + k] = g0[k]; gr[8 * j + 4 + k] = g1[k]; br[8 * j + k] = b0[k]; br[8 * j + 4 + k] = b1[k]; } }
}
template <bool F32OUT>
__device__ __forceinline__ void ln_store16(float (&v)[16], const float (&gr)[16], const float (&br)[16], float* orow, bf16* brow, int lane) {
    float s = 0.f;
#pragma unroll
    for (int i = 0; i < 16; ++i) s += v[i];
    const float mean = wave_sum(s) * (1.f / D); float s2 = 0.f;
#pragma unroll
    for (int i = 0; i < 16; ++i) { v[i] -= mean; s2 += v[i] * v[i]; }
    const float rstd = 1.f / sqrtf(wave_sum(s2) * (1.f / D) + LN_EPS);
#pragma unroll
    for (int j = 0; j < 2; ++j) { const int c = 8 * lane + 512 * j;
        f32x4 y0, y1;
#pragma unroll
        for (int k = 0; k < 4; ++k) { y0[k] = v[8 * j + k] * rstd * gr[8 * j + k] + br[8 * j + k]; y1[k] = v[8 * j + 4 + k] * rstd * gr[8 * j + 4 + k] + br[8 * j + 4 + k]; }
        if constexpr (F32OUT) { *(f32x4*)(orow + c) = y0; *(f32x4*)(orow + c + 4) = y1; }
        else { u32x4 w; w.x = cvt_pk_bf16(y0[0], y0[1]); w.y = cvt_pk_bf16(y0[2], y0[3]); w.z = cvt_pk_bf16(y1[0], y1[1]); w.w = cvt_pk_bf16(y1[2], y1[3]); *(u32x4*)(brow + c) = w; } }
}
__device__ __forceinline__ void unpack8(const u32x4 w, float* v) { v[0] = bf_lo(w.x); v[1] = bf_hi(w.x); v[2] = bf_lo(w.y); v[3] = bf_hi(w.y); v[4] = bf_lo(w.z); v[5] = bf_hi(w.z); v[6] = bf_lo(w.w); v[7] = bf_hi(w.w); }

#ifndef ACT_ON
#define ACT_ON 1
#endif
#ifndef STAG_TICKS
#define STAG_TICKS 1500
#endif
#ifndef PROBE_CLK
#define PROBE_CLK 0
#endif
#ifndef PROBE_P0
#define PROBE_P0 1
#endif
#ifndef PROBE_ATTN
#define PROBE_ATTN 1
#endif
#ifndef PROBE_NOSTORE
#define PROBE_NOSTORE 0
#endif
#ifndef PROBE_QKV
#define PROBE_QKV 1
#endif
#ifndef PROBE_WO
#define PROBE_WO 1
#endif
#ifndef PROBE_GIN
#define PROBE_GIN 1
#endif
#ifndef PROBE_MOE
#define PROBE_MOE 1
#endif
#ifndef PHASES
#define PHASES 0xFFFF
#endif
#define PH(k) ((PHASES >> (k)) & 1)
struct Params { const float* in[22]; float* out; unsigned char* ws; };
#define CLK_BEGIN() unsigned long long c0_ = __builtin_amdgcn_s_memtime(), r0_ = __builtin_amdgcn_s_memrealtime()
#define CLK_END() do { const unsigned long long dc_ = __builtin_amdgcn_s_memtime() - c0_, dr_ = __builtin_amdgcn_s_memrealtime() - r0_; \
    if (blockIdx.x == 0) { const unsigned long long w_ = 10000ull * dc_ / (dr_ ? dr_ : 1ull); const unsigned long long t0_ = __builtin_amdgcn_s_memrealtime(); \
        while (__builtin_amdgcn_s_memrealtime() - t0_ < w_) __builtin_amdgcn_s_sleep(8); } } while (0)
__device__ __forceinline__ void stagger(int bx, unsigned ticks) {
    if ((bx >> 3) & 1) { const unsigned long long t0 = __builtin_amdgcn_s_memrealtime(); while (__builtin_amdgcn_s_memrealtime() - t0 < ticks) __builtin_amdgcn_s_sleep(8); }
}
enum { I_X = 0, I_RELB, I_AWIN, I_AWOUT, I_ALAM, I_ASUBG, I_SGWIN, I_SGBIN, I_SGLNG, I_SGLNB, I_SGWS, I_SGBS, I_SGWOUT,
       I_MWG, I_MBG, I_MWR, I_MBR, I_MWGATE, I_MWUP, I_MWDOWN, I_LNG, I_LNB };
typedef const __attribute__((address_space(4))) Params* kparams_t;
#define LAUNDER_S(x) ({ int _v = (x); asm volatile("" : "+s"(_v)); _v; })
#define KP() ({ kparams_t _k = (kparams_t)__builtin_amdgcn_kernarg_segment_ptr(); asm volatile("" : "+s"(_k)); _k; })

__global__ void __launch_bounds__(NTHREADS, 2) mega_fwd(Params p_unused) {
    extern __shared__ __attribute__((aligned(16))) unsigned char lds_raw[];
    lds_u8* lds = (lds_u8*)lds_raw;
    const int G0 = gridDim.x, bx0 = blockIdx.x;
    const int wv = __builtin_amdgcn_readfirstlane(threadIdx.x >> 6);
#define PHASE_IDS() const int tid = tid_opaque(wv), lane = tid & 63, wave = wv; (void)lane; (void)wave; \
    const int bxp = LAUNDER_S(bx0), Gp = LAUNDER_S(G0), vcu = (Gp % 8 == 0) ? (bxp % 8) * (Gp / 8) + bxp / 8 : bxp; (void)vcu; \
    const int gw = vcu * NWAVES + wave, ngw = Gp * NWAVES, gtid = bxp * NTHREADS + tid, ngt = Gp * NTHREADS; (void)gw; (void)ngw; (void)gtid; (void)ngt
    for (int u = threadIdx.x; u < (LDS_BYTES - LDSCTL_OFF) / 4; u += NTHREADS) ((LAS unsigned*)(lds + LDSCTL_OFF))[u] = 0u;
    __syncthreads();
    XcdBarrier bar;
    { kparams_t kp = KP(); const int bx = LAUNDER_S(bx0), G = LAUNDER_S(G0); (void)bx; (void)G; bar = xcd_barrier_post((unsigned*)(kp->ws + WS_CTL) + 4096, (volatile LAS unsigned*)(lds + L_MISC), wv); }
#define GRID_BAR() xcd_barrier(bar)

#pragma unroll 1
    for (int rep_ = 0; rep_ < PROBE_P0; ++rep_)
    if (PH(0)) {
        PHASE_IDS(); kparams_t kp = KP(); const int bx = LAUNDER_S(bx0), G = LAUNDER_S(G0); (void)bx; (void)G; unsigned char* ws = kp->ws;
        LAS float* scr = (LAS float*)(lds + wave * 16384);
        transpose_matrix(kp->in[I_AWOUT], D, D, (bf16*)(ws + WS_WO), scr, gw, ngw, lane);
        transpose_matrix(kp->in[I_SGWIN], D, 2 * SGH, (bf16*)(ws + WS_W1), scr, gw, ngw, lane);
        transpose_matrix(kp->in[I_SGWOUT], SGH, D, (bf16*)(ws + WS_W2), scr, gw, ngw, lane);
        convert_moe(kp->in[I_MWGATE], kp->in[I_MWUP], kp->in[I_MWDOWN], (bf16*)(ws + WS_MOE1), (bf16*)(ws + WS_MOE2), scr, gw, ngw, lane);
        { const float* wgp = kp->in[I_MWG]; const float* wrp = kp->in[I_MWR]; bf16* wr_t = (bf16*)(ws + WS_WR);
          for (int i = gtid; i < 2 * 256 * D; i += ngt) { const int l = i / (256 * D), n = (i / D) % 256, k = i % D;
              float v = 0.f; if (n < 8) v = wgp[(size_t)l * D * 8 + k * 8 + n]; else if (n < 72) v = wrp[(size_t)l * D * 64 + k * 64 + (n - 8)];
              wr_t[i] = (bf16)(cvt_pk_bf16(v, 0.f) & 0xffffu); } }
        { const float* w_s = kp->in[I_SGWS]; bf16* wtril = (bf16*)(ws + WS_WTRIL);
          for (int i = gtid; i < SGG * SGC * SGC; i += ngt) { const int t = (i / SGC) % SGC, s_ = i % SGC; const float v = (s_ <= t) ? w_s[i] : 0.f; wtril[i] = (bf16)(cvt_pk_bf16(v, 0.f) & 0xffffu); } }
        { const float* rel_bias = kp->in[I_RELB]; float* dtab = (float*)(ws + WS_DTAB);
          for (int i = gtid; i < NHEAD * 128; i += ngt) { const int h = i / 128, d = i % 128; dtab[i] = (rel_bias[t5_bucket(d) * NHEAD + h] - rel_bias[31 * NHEAD + h]) * LOG2E; } }
        transpose_matrix(kp->in[I_AWIN], D, NQKV, (bf16*)(ws + WS_WQKV), scr, gw, ngw, lane);
        { const float* x = kp->in[I_X]; bf16* hb = (bf16*)(ws + WS_HB);
#pragma unroll 4
          for (size_t i = gtid; i < (size_t)NTOK * D / 8; i += ngt) { const f32x4 a = __builtin_nontemporal_load((const f32x4*)(x + i * 8)), b = __builtin_nontemporal_load((const f32x4*)(x + i * 8 + 4));
              u32x4 w; w.x = cvt_pk_bf16(a.x, a.y); w.y = cvt_pk_bf16(a.z, a.w); w.z = cvt_pk_bf16(b.x, b.y); w.w = cvt_pk_bf16(b.z, b.w); *(u32x4*)(hb + i * 8) = w; } }
    }
    GRID_BAR();

#pragma unroll 1
    for (int layer = 0; layer < 2; ++layer) {
        if (layer == 0) {
            _Pragma("unroll 1") for (int rep_ = 0; rep_ < PROBE_QKV; ++rep_)
            if (PH(1)) { kparams_t kp = KP(); const int bx = LAUNDER_S(bx0), G = LAUNDER_S(G0); (void)bx; (void)G; unsigned char* ws = kp->ws;
              pg8::Gemm g{(const bf16*)(ws + WS_HB), (const bf16*)(ws + WS_WQKV), D, 0}; pg8::StaticOrder S{NTOK / 256, NQKV / 256, G, bx};
              pg8::EpiBf16<0> E{(bf16*)(ws + WS_QKV), NQKV, nullptr, D, (size_t)D, 0.125f * LOG2E, PROBE_NOSTORE ? rep_ : 0, nullptr};
              pg8::gemm_phase<pg8::EpiBf16<0>, pg8::StaticOrder, true, false>(lds, g, S, E, wv); }
#ifdef PROBE_NULLQKV
            { kparams_t kp = KP(); const int bx = LAUNDER_S(bx0), G = LAUNDER_S(G0); (void)bx; (void)G; unsigned char* ws = kp->ws;
              pg8::Gemm g{(const bf16*)(ws + WS_HB), (const bf16*)(ws + WS_WQKV), D, 0}; pg8::StaticOrder S{NTOK / 256, NQKV / 256, G, bx};
              pg8::EpiNull E{(f32x4*)(ws + WS_OB)};
              pg8::gemm_phase<pg8::EpiNull, pg8::StaticOrder, true, false>(lds, g, S, E, wv); }
#endif
            GRID_BAR();
#if PROBE_CLK == 1
            CLK_BEGIN();
#endif
            if (PH(2)) { PHASE_IDS(); kparams_t kp = KP(); const int bx = LAUNDER_S(bx0), G = LAUNDER_S(G0); (void)bx; (void)G; unsigned char* ws = kp->ws;
              float lam;
              { const float* al = kp->in[I_ALAM]; const float a = al[lane] * al[64 + lane], b = al[128 + lane] * al[192 + lane];
                lam = __expf(wave_sum(a)) - __expf(wave_sum(b)) + 0.2f; }
              const int grp = vcu >> 3, jj = vcu & 7;
#pragma unroll 1
              for (int i = 0; i < 8 * PROBE_ATTN; ++i) { const int bh = grp * 4 + ((i & 7) >> 1); const int qt = (i & 1) ? jj : 15 - jj;
                  da::attn_unit(bh >> 3, bh & 7, qt, (const bf16*)(ws + WS_QKV), (bf16*)(ws + WS_OB), (const float*)(ws + WS_DTAB), kp->in[I_ASUBG], lam, lds, wv); } }
#if PROBE_CLK == 1
            CLK_END();
#endif
            GRID_BAR();
            _Pragma("unroll 1") for (int rep_ = 0; rep_ < PROBE_WO; ++rep_)
            if (PH(3)) { kparams_t kp = KP(); const int bx = LAUNDER_S(bx0), G = LAUNDER_S(G0); (void)bx; (void)G; unsigned char* ws = kp->ws;
              pg8::Gemm g{(const bf16*)(ws + WS_OB), (const bf16*)(ws + WS_WO), D, 0}; pg8::RowOrder S{bx, D / 256};
              pg8::EpiResBf16 E{(const bf16*)(ws + WS_HB), (bf16*)(ws + WS_HB), D, DN_ALPHA};
              pg8::gemm_phase<pg8::EpiResBf16, pg8::RowOrder, true, false>(lds, g, S, E, wv); }
            VM_WAIT(); __syncthreads(); __builtin_amdgcn_fence(__ATOMIC_ACQUIRE, "agent"); VM_WAIT(); __syncthreads();
        } else {
#if PROBE_CLK == 2
            CLK_BEGIN();
#endif
            _Pragma("unroll 1") for (int rep_ = 0; rep_ < PROBE_GIN; ++rep_)
            if (PH(4)) { kparams_t kp = KP(); const int bx = LAUNDER_S(bx0), G = LAUNDER_S(G0); (void)bx; (void)G; unsigned char* ws = kp->ws;
              pg8::Gemm g{(const bf16*)(ws + WS_HB), (const bf16*)(ws + WS_W1), D, 0}; pg8::StaticOrder S{NTOK / 256, 2 * SGH / 256, G, bx};
              pg8::EpiBf16<1> E{(bf16*)(ws + WS_U), SGH, kp->in[I_SGBIN], SGH, (size_t)(WS_V - WS_U) / 2, 1.f, PROBE_NOSTORE ? rep_ : 0, (f32x2*)(ws + WS_VSTAT)};
              pg8::gemm_phase<pg8::EpiBf16<1>, pg8::StaticOrder, true, false>(lds, g, S, E, wv); }
#if PROBE_CLK == 2
            CLK_END();
#endif
            GRID_BAR();
            if (PH(5)) { kparams_t kp = KP(); const int bx = LAUNDER_S(bx0), G = LAUNDER_S(G0); (void)bx; (void)G; unsigned char* ws = kp->ws;
#pragma unroll 1
              for (int ch = bx; ch < NTOK / SGC; ch += G)
                  sg::chunk_unit(ch, (bf16*)(ws + WS_U), (const bf16*)(ws + WS_V), (const f32x2*)(ws + WS_VSTAT), kp->in[I_SGLNG], kp->in[I_SGLNB], (const bf16*)(ws + WS_WTRIL), kp->in[I_SGBS], lds, wv); }
            GRID_BAR();
            if (PH(6)) { PHASE_IDS(); kparams_t kp = KP(); const int bx = LAUNDER_S(bx0), G = LAUNDER_S(G0); (void)bx; (void)G; unsigned char* ws = kp->ws;
              LAS float* scr = (LAS float*)(lds + wave * 16384);
              convert_moe(kp->in[I_MWGATE] + (size_t)NEXP * D * MOEH, kp->in[I_MWUP] + (size_t)NEXP * D * MOEH, kp->in[I_MWDOWN] + (size_t)NEXP * MOEH * D,
                          (bf16*)(ws + WS_MOE1), (bf16*)(ws + WS_MOE2), scr, gw, ngw, lane);
              __syncthreads(); }
            if (PH(6)) { kparams_t kp = KP(); const int bx = LAUNDER_S(bx0), G = LAUNDER_S(G0); (void)bx; (void)G; unsigned char* ws = kp->ws;
              pg8::Gemm g{(const bf16*)(ws + WS_U), (const bf16*)(ws + WS_W2), SGH, 0}; pg8::StaticOrder S{NTOK / 256, D / 256, G, bx};
              pg8::EpiResBf16 E{(const bf16*)(ws + WS_HB), (bf16*)(ws + WS_HB), D, DN_ALPHA};
              pg8::gemm_phase<pg8::EpiResBf16, pg8::StaticOrder, true, false>(lds, g, S, E, wv); }
            GRID_BAR();
        }
        if (PH(7)) {
            PHASE_IDS();
            { kparams_t kp = KP(); const int bx = LAUNDER_S(bx0), G = LAUNDER_S(G0); (void)bx; (void)G; unsigned char* ws = kp->ws; bf16* hb = (bf16*)(ws + WS_HB);
              const float* g1 = kp->in[I_LNG] + (size_t)(layer * 2 + 0) * D; const float* b1 = kp->in[I_LNB] + (size_t)(layer * 2 + 0) * D;
              float gr[16], br[16]; ln_params(g1, b1, gr, br, lane); __builtin_amdgcn_s_waitcnt(0x0F70);
              u32x4 q[4][2]; const size_t row0 = (size_t)bx * 256 + wave * 32;
#define LN1_LOAD(K, ROW) do { const bf16* r_ = hb + (ROW) * D + 8 * lane; GLOAD16(q[K][0], r_, 0); GLOAD16(q[K][1], r_, 1024); } while (0)
#define LN1_WAIT(K, N) asm volatile("s_waitcnt vmcnt(" #N ")" : "+v"(q[K][0]), "+v"(q[K][1]) :: "memory")
#define LN1_PROC(K, ROW) do { float va[16]; unpack8(q[K][0], va); unpack8(q[K][1], va + 8); ln_store16<false>(va, gr, br, nullptr, hb + (ROW) * D, lane); } while (0)
#define LN1_ITER(ROW, N0, N1, N2, N3) do { const size_t row = (ROW); \
    LN1_LOAD(3, row + 3); LN1_WAIT(0, N0); LN1_PROC(0, row); LN1_LOAD(0, row + 4); LN1_WAIT(1, N1); LN1_PROC(1, row + 1); LN1_LOAD(1, row + 5); LN1_WAIT(2, N2); LN1_PROC(2, row + 2); \
    LN1_LOAD(2, row + 6); LN1_WAIT(3, N3); LN1_PROC(3, row + 3); } while (0)
              LN1_LOAD(0, row0); LN1_LOAD(1, row0 + 1); LN1_LOAD(2, row0 + 2);
              LN1_ITER(row0, 6, 8, 10, 12);
#pragma unroll 1
              for (int i = 4; i < 28; i += 4) LN1_ITER(row0 + i, 12, 12, 12, 12);
              { const size_t row = row0 + 28; LN1_LOAD(3, row + 3); LN1_WAIT(0, 12); LN1_PROC(0, row); LN1_WAIT(1, 10); LN1_PROC(1, row + 1); LN1_WAIT(2, 8); LN1_PROC(2, row + 2); LN1_WAIT(3, 6); LN1_PROC(3, row + 3); }
#undef LN1_ITER
#undef LN1_LOAD
#undef LN1_WAIT
#undef LN1_PROC
              VM_WAIT(); __builtin_amdgcn_fence(__ATOMIC_ACQUIRE, "agent"); VM_WAIT(); __syncthreads(); }
            { kparams_t kp = KP(); const int bx = LAUNDER_S(bx0), G = LAUNDER_S(G0); (void)bx; (void)G; unsigned char* ws = kp->ws;
              pg8::Gemm g{(const bf16*)(ws + WS_HB), (const bf16*)(ws + WS_WR) + (size_t)layer * 256 * D, D, 0}; pg8::SingleOrder S{bx};
              pg8::EpiRouter E{kp->in[I_MBG] + layer * 8, kp->in[I_MBR] + layer * 64};
              pg8::gemm_phase<pg8::EpiRouter, pg8::SingleOrder, false, false>(lds, g, S, E, wv); }
            LAS int* wcnt = (LAS int*)(lds + L_WCNT);
            if (tid < 64) wcnt[tid] = 0;
            __syncthreads();
            if (tid < 256) { kparams_t kp = KP(); const int bx = LAUNDER_S(bx0), G = LAUNDER_S(G0); (void)bx; (void)G; unsigned char* ws = kp->ws; int* aexp = (int*)(ws + WS_AEXP); float* agate = (float*)(ws + WS_AGATE);
                const LAS float* lg = (const LAS float*)lds + tid * 73;
                float gmax = lg[0]; int gi = 0;
#pragma unroll
                for (int j = 1; j < 8; ++j) { const float v = lg[j]; if (v > gmax) { gmax = v; gi = j; } }
                float gs = 0.f;
#pragma unroll
                for (int j = 0; j < 8; ++j) gs += __expf(lg[j] - gmax);
                const float ggate = 1.0f / gs;
                const LAS float* el = lg + 8 + gi * 8;
                float v1 = el[0]; int i1 = 0;
#pragma unroll
                for (int j = 1; j < 8; ++j) { const float v = el[j]; if (v > v1) { v1 = v; i1 = j; } }
                float v2 = -INFINITY; int i2 = 0;
#pragma unroll
                for (int j = 0; j < 8; ++j) { const float v = el[j]; if (j != i1 && v > v2) { v2 = v; i2 = j; } }
                const float e2 = __expf(v2 - v1), p1 = 1.0f / (1.0f + e2), p2 = e2 * p1;
                const int tok = bx * 256 + tid; const int e1x = gi * 8 + i1, e2x = gi * 8 + i2;
                aexp[2 * tok] = e1x; aexp[2 * tok + 1] = e2x; agate[2 * tok] = ggate * p1; agate[2 * tok + 1] = ggate * p2;
                atomicAdd((int*)&wcnt[e1x], 1); atomicAdd((int*)&wcnt[e2x], 1); }
            __syncthreads();
            if (tid < 64) { kparams_t kp = KP(); const int bx = LAUNDER_S(bx0), G = LAUNDER_S(G0); (void)bx; (void)G; int* hist = (int*)(kp->ws + WS_HIST); hist[bx * 64 + tid] = wcnt[tid]; }
        }
        GRID_BAR();
        LAS int* pstL = (LAS int*)(lds + L_PST);
        if (PH(8)) {
            PHASE_IDS(); kparams_t kp = KP(); const int bx = LAUNDER_S(bx0), G = LAUNDER_S(G0); (void)bx; (void)G; unsigned char* ws = kp->ws; const int* hist = (const int*)(ws + WS_HIST); const int* aexp = (const int*)(ws + WS_AEXP); unsigned* srt = (unsigned*)(ws + WS_SRT);
            LAS int* cntL = (LAS int*)(lds + L_CNT);
            LAS int* offsL = (LAS int*)(lds + L_OFFS); LAS int* wcnt = (LAS int*)(lds + L_WCNT); LAS int* part = (LAS int*)(lds + L_PART);
            { const int e = tid & 63, pt = tid >> 6; int sa = 0, sb = 0;
              for (int w = pt * 32; w < pt * 32 + 32; ++w) { const int hv = hist[w * 64 + e]; sa += hv; if (w < bx) sb += hv; }
              part[pt * 64 + e] = sa; part[512 + pt * 64 + e] = sb; }
            __syncthreads();
            if (tid < 64) { int sa = 0, sb = 0;
#pragma unroll
                for (int pt = 0; pt < 8; ++pt) { sa += part[pt * 64 + tid]; sb += part[512 + pt * 64 + tid]; }
                cntL[tid] = sa; offsL[tid] = sb; wcnt[tid] = 0; }
            __syncthreads();
            if (tid == 0) { int acc = 0; for (int e = 0; e < 64; ++e) { pstL[e] = acc; acc += (cntL[e] + 255) & ~255; } pstL[64] = acc; pstL[65] = acc; pstL[66] = acc; pstL[67] = acc; }
            __syncthreads();
            if (tid < 256) { const int tok = bx * 256 + tid;
#pragma unroll
                for (int k = 0; k < 2; ++k) { const int a = 2 * tok + k; const int e = aexp[a]; const int rank = atomicAdd((int*)&wcnt[e], 1);
                    srt[pstL[e] + offsL[e] + rank] = (unsigned)a; } }
            if (bx < 64) { const int e = bx; const int c = cntL[e], cp = (c + 255) & ~255; for (int i = c + tid; i < cp; i += NTHREADS) srt[pstL[e] + i] = SRT_MARK; }
        }
        GRID_BAR();
        _Pragma("unroll 1") for (int rep_ = 0; rep_ < PROBE_MOE; ++rep_)
            if (PH(9)) { kparams_t kp = KP(); const int bx = LAUNDER_S(bx0), G = LAUNDER_S(G0); (void)bx; (void)G; unsigned char* ws = kp->ws; const int ntile = pstL[64] >> 8;
          pg8::Gemm g{(const bf16*)(ws + WS_HB), (const bf16*)(ws + WS_MOE1), D, (size_t)D * D * 2}; pg8::MoeOrder S{ntile, G, bx, pstL, (const unsigned*)(ws + WS_SRT), true};
          pg8::EpiSwiglu E{(bf16*)(ws + WS_HM)};
          pg8::gemm_phase<pg8::EpiSwiglu, pg8::MoeOrder, true, true>(lds, g, S, E, wv); }
        GRID_BAR();
        _Pragma("unroll 1") for (int rep_ = 0; rep_ < PROBE_MOE; ++rep_)
            if (PH(10)) { kparams_t kp = KP(); const int bx = LAUNDER_S(bx0), G = LAUNDER_S(G0); (void)bx; (void)G; unsigned char* ws = kp->ws; const int ntile = pstL[64] >> 8;
          pg8::Gemm g{(const bf16*)(ws + WS_HM), (const bf16*)(ws + WS_MOE2), MOEH, (size_t)D * MOEH * 2}; pg8::MoeOrder S{ntile, G, bx, pstL, (const unsigned*)(ws + WS_SRT), false};
          pg8::EpiScatter E{(unsigned char*)(ws + WS_YSLOT), (const unsigned*)(ws + WS_SRT), (const float*)(ws + WS_AGATE)};
          pg8::gemm_phase<pg8::EpiScatter, pg8::MoeOrder, true, false>(lds, g, S, E, wv); }
        GRID_BAR();
        if (PH(11)) {
            PHASE_IDS(); kparams_t kp = KP(); const int bx = LAUNDER_S(bx0), G = LAUNDER_S(G0); (void)bx; (void)G; unsigned char* ws = kp->ws; float* out = kp->out; bf16* hb = (bf16*)(ws + WS_HB); const unsigned char* yslot = (const unsigned char*)(ws + WS_YSLOT);
            const float* g2 = kp->in[I_LNG] + (size_t)(layer * 2 + 1) * D; const float* b2 = kp->in[I_LNB] + (size_t)(layer * 2 + 1) * D;
            const size_t row0 = (size_t)bx * 256 + wave * 32;
            float gr[16], br[16]; ln_params(g2, b2, gr, br, lane); __builtin_amdgcn_s_waitcnt(0x0F70);
            u32x4 hq[4][2]; u32x2 aq[4][2], bq[4][2];
#define LN2_LOAD(K, ROW) do { const bf16* hr_ = hb + (ROW) * D + 8 * lane; const unsigned char* y0_ = yslot + (2 * (ROW)) * D + 8 * lane; \
    GLOAD16(hq[K][0], hr_, 0); GLOAD16(hq[K][1], hr_, 1024); GLOAD8(aq[K][0], y0_, 0); GLOAD8(aq[K][1], y0_, 512); GLOAD8(bq[K][0], y0_, 1024); GLOAD8(bq[K][1], y0_, 1536); } while (0)
#define LN2_WAIT_(K, N) asm volatile("s_waitcnt vmcnt(" #N ")" : "+v"(hq[K][0]), "+v"(hq[K][1]), "+v"(aq[K][0]), "+v"(aq[K][1]), "+v"(bq[K][0]), "+v"(bq[K][1]) :: "memory")
#define LN2_WAIT(K, NA, NB) do { if (L0) LN2_WAIT_(K, NA); else LN2_WAIT_(K, NB); } while (0)
#define Y4(Q) v[8 * j + Q] = h8[Q] * DN_ALPHA + (__builtin_amdgcn_cvt_f32_fp8((int)a.x, Q) + __builtin_amdgcn_cvt_f32_fp8((int)b.x, Q)) * YINV; \
              v[8 * j + 4 + Q] = h8[4 + Q] * DN_ALPHA + (__builtin_amdgcn_cvt_f32_fp8((int)a.y, Q) + __builtin_amdgcn_cvt_f32_fp8((int)b.y, Q)) * YINV
#define LN2_PROC(K, ROW) do { float v[16]; \
    _Pragma("unroll") for (int j = 0; j < 2; ++j) { float h8[8]; unpack8(hq[K][j], h8); const u32x2 a = aq[K][j], b = bq[K][j]; Y4(0); Y4(1); Y4(2); Y4(3); } \
    if (L0) ln_store16<false>(v, gr, br, nullptr, hb + (ROW) * D, lane); else ln_store16<true>(v, gr, br, out + (ROW) * D, nullptr, lane); } while (0)
#define LN2_ITER(ROW, A0, B0, A1, B1, A2, B2, A3, B3) do { const size_t row = (ROW); \
    LN2_LOAD(3, row + 3); LN2_WAIT(0, A0, B0); LN2_PROC(0, row); LN2_LOAD(0, row + 4); LN2_WAIT(1, A1, B1); LN2_PROC(1, row + 1); LN2_LOAD(1, row + 5); LN2_WAIT(2, A2, B2); LN2_PROC(2, row + 2); \
    LN2_LOAD(2, row + 6); LN2_WAIT(3, A3, B3); LN2_PROC(3, row + 3); } while (0)
#define LN2_SWEEP() do { LN2_LOAD(0, row0); LN2_LOAD(1, row0 + 1); LN2_LOAD(2, row0 + 2); \
            LN2_ITER(row0, 18, 18, 20, 22, 22, 26, 24, 30); \
            _Pragma("unroll 1") for (int i = 4; i < 28; i += 4) LN2_ITER(row0 + i, 24, 30, 24, 30, 24, 30, 24, 30); \
            { const size_t row = row0 + 28; LN2_LOAD(3, row + 3); LN2_WAIT(0, 24, 30); LN2_PROC(0, row); LN2_WAIT(1, 18, 24); LN2_PROC(1, row + 1); LN2_WAIT(2, 12, 18); LN2_PROC(2, row + 2); \
              LN2_WAIT(3, 6, 12); LN2_PROC(3, row + 3); } } while (0)
            if (layer == 0) { constexpr bool L0 = true; LN2_SWEEP(); } else { constexpr bool L0 = false; LN2_SWEEP(); }
#undef LN2_SWEEP
#undef LN2_ITER
#undef LN2_WAIT
#undef LN2_WAIT_
#undef LN2_LOAD
#undef LN2_PROC
#undef Y4
        }
        if (layer == 0) GRID_BAR();
    }
}

extern "C" void kernel_launch(void* const* d_in, const int* in_sizes, int n_in, void* d_out, int out_size, void* d_ws, size_t ws_size, hipStream_t stream) {
    static int ok = 0;
    if (ok == 0) {
        if (n_in != 22 || in_sizes[0] != NTOK * D || out_size != NTOK * D || ws_size < WS_END) {
            fprintf(stderr, "kernel_launch: shape mismatch: n_in %d in0 %d out %d ws %zu (need %zu)\n", n_in, n_in > 0 ? in_sizes[0] : -1, out_size, ws_size, (size_t)WS_END); ok = -1; return; }
        if (hipFuncSetAttribute((const void*)mega_fwd, hipFuncAttributeMaxDynamicSharedMemorySize, LDS_BYTES) != hipSuccess) { fprintf(stderr, "kernel_launch: hipFuncSetAttribute failed\n"); ok = -1; return; }
        int per_cu = 0;
        if (hipOccupancyMaxActiveBlocksPerMultiprocessor(&per_cu, (const void*)mega_fwd, NTHREADS, LDS_BYTES) != hipSuccess || per_cu < 1)
            fprintf(stderr, "kernel_launch: occupancy query reports %d workgroups per CU\n", per_cu);
        (void)hipGetLastError();
        ok = 1;
    }
    if (ok < 0) return;
    if (hipMemsetAsync((char*)d_ws + WS_CTL, 0, CTL_ZERO_BYTES, stream) != hipSuccess) { fprintf(stderr, "kernel_launch: memset failed\n"); return; }
    Params p{};
    for (int i = 0; i < 22; ++i) p.in[i] = (const float*)d_in[i];
    p.out = (float*)d_out; p.ws = (unsigned char*)d_ws;
    hipLaunchKernelGGL(mega_fwd, dim3(GRID), dim3(NTHREADS), LDS_BYTES, stream, p);
    const hipError_t le = hipPeekAtLastError();
    if (le != hipSuccess) fprintf(stderr, "kernel_launch: launch failed: %s\n", hipGetErrorName(le));
}
```

```cpp
#ifndef ACT_ON
#define ACT_ON 1
#endif
#include <hip/hip_runtime.h>
#include <hip/hip_bf16.h>
#include <cstdio>
#include <cstdint>

#define LAS __attribute__((address_space(3)))
#define GAS __attribute__((address_space(1)))
typedef unsigned short bf16;
typedef short bf16x8 __attribute__((ext_vector_type(8)));
typedef short s16x4 __attribute__((ext_vector_type(4)));
typedef float f32x4 __attribute__((ext_vector_type(4)));
typedef float f32x2 __attribute__((ext_vector_type(2)));
typedef float f32x16 __attribute__((ext_vector_type(16)));
typedef unsigned u32x4 __attribute__((ext_vector_type(4)));
typedef unsigned u32x2 __attribute__((ext_vector_type(2)));
typedef LAS unsigned char lds_u8;

constexpr int D = 1024, BATCH = 16, SEQ = 4096, NTOK = BATCH * SEQ;
constexpr int NQKV = 3072, NHEAD = 8;
constexpr int SGH = 3072, SGG = 8, SGC = 128, SGGD = 384;
constexpr int NEXP = 64, MOEH = 512, NASG = NTOK * 2;
constexpr int PMAX = NASG + NEXP * 256;
constexpr float LN_EPS = 1e-5f, DN_ALPHA = 1.4142135623730951f;
constexpr float LOG2E = 1.4426950408889634f;
constexpr unsigned SRT_MARK = 0xFFFFFFFFu;
constexpr float YSCALE = 16.0f, YINV = 1.0f / 16.0f;
constexpr int NWAVES = 8, NTHREADS = 512, GRID = 256;

constexpr size_t MiB = 1u << 20;
constexpr size_t WS_CTL = 0, CTL_ZERO_BYTES = 1 * MiB;
constexpr size_t WS_DTAB = 1 * MiB;
constexpr size_t WS_WTRIL = 1 * MiB + 65536;
constexpr size_t WS_WR = 2 * MiB;
constexpr size_t WS_HIST = 3 * MiB;
constexpr size_t WS_AEXP = 4 * MiB;
constexpr size_t WS_AGATE = 5 * MiB;
constexpr size_t WS_SRT = 6 * MiB;
constexpr size_t WS_WQKV = 8 * MiB;
constexpr size_t WS_WO = 14 * MiB;
constexpr size_t WS_W1 = 16 * MiB;
constexpr size_t WS_W2 = 28 * MiB;
constexpr size_t WS_HB = 34 * MiB;
constexpr size_t WS_ARENA = 162 * MiB;
constexpr size_t WS_QKV = WS_ARENA;
constexpr size_t WS_OB = WS_ARENA + 384 * MiB;
constexpr size_t WS_YSLOT = WS_ARENA;
constexpr size_t WS_HM = WS_ARENA + 256 * MiB;
constexpr size_t WS_U = WS_ARENA;
constexpr size_t WS_V = WS_ARENA + 384 * MiB;
constexpr size_t WS_MOE1 = WS_ARENA + 576 * MiB;
constexpr size_t WS_MOE2 = WS_MOE1 + 128 * MiB;
constexpr size_t WS_VSTAT = WS_MOE2 + 64 * MiB;
constexpr size_t WS_END = WS_VSTAT + 26 * MiB;
static_assert(WS_HM + (size_t)PMAX * MOEH * 2 <= WS_MOE1, "ws map");
static_assert(WS_V + (size_t)NTOK * SGH * 2 <= WS_END, "ws map");

constexpr int RING_BYTES = 131072;
constexpr int LDSCTL_OFF = 139264;
constexpr int L_MISC = LDSCTL_OFF;
constexpr int L_CNT = LDSCTL_OFF + 64;
constexpr int L_PST = L_CNT + 256;
constexpr int L_OFFS = L_PST + 272;
constexpr int L_WCNT = L_OFFS + 256;
constexpr int L_PART = L_WCNT + 256;
constexpr int L_END = L_PART + 4096;
constexpr int LDS_BYTES = 147456;
static_assert(L_END <= LDS_BYTES, "LDS map");

__device__ __forceinline__ unsigned cvt_pk_bf16(float lo, float hi) { unsigned r; asm volatile("v_cvt_pk_bf16_f32 %0, %1, %2" : "=v"(r) : "v"(lo), "v"(hi)); return r; }
__device__ __forceinline__ float clamp_e4m3(float x) { return __builtin_amdgcn_fmed3f(x, -448.0f, 448.0f); }
__device__ __forceinline__ unsigned pk4_fp8(float a, float b, float c, float d) { int w = 0; w = __builtin_amdgcn_cvt_pk_fp8_f32(clamp_e4m3(a), clamp_e4m3(b), w, false); w = __builtin_amdgcn_cvt_pk_fp8_f32(clamp_e4m3(c), clamp_e4m3(d), w, true); return (unsigned)w; }
__device__ __forceinline__ float bf_lo(unsigned w) { return __uint_as_float(w << 16); }
__device__ __forceinline__ float bf_hi(unsigned w) { return __uint_as_float(w & 0xffff0000u); }
__device__ __forceinline__ float wave_sum(float v) {
#define WS_DPP(X, CTRL, RM) __builtin_bit_cast(float, __builtin_amdgcn_update_dpp(0, __builtin_bit_cast(int, X), CTRL, RM, 0xf, false))
    v += WS_DPP(v, 0xB1, 0xf);
    v += WS_DPP(v, 0x4E, 0xf);
    v += WS_DPP(v, 0x141, 0xf);
    v += WS_DPP(v, 0x140, 0xf);
    v += WS_DPP(v, 0x142, 0xa);
    v += WS_DPP(v, 0x143, 0xc);
#undef WS_DPP
    return __builtin_bit_cast(float, __builtin_amdgcn_readlane(__builtin_bit_cast(int, v), 63));
}
__device__ __forceinline__ float gelu_tanh(float x) {
    const float inner = x * (1.0f + 0.044715f * x * x);
    const float e = __builtin_amdgcn_exp2f(-2.302208198f * inner);
    return x * __builtin_amdgcn_rcpf(1.0f + e);
}
__device__ __forceinline__ f32x2 gelu_tanh2(f32x2 x) {
    const f32x2 x2 = x * x, inner = x * (x2 * (-2.302208198f * 0.044715f) + (-2.302208198f));
    f32x2 e; e.x = __builtin_amdgcn_exp2f(inner.x); e.y = __builtin_amdgcn_exp2f(inner.y);
    const f32x2 d = e + 1.0f; f32x2 r; r.x = __builtin_amdgcn_rcpf(d.x); r.y = __builtin_amdgcn_rcpf(d.y);
    return x * r;
}
__device__ __forceinline__ float silu_f(float x) { return x * __builtin_amdgcn_rcpf(1.0f + __builtin_amdgcn_exp2f(-LOG2E * x)); }
__device__ __forceinline__ int lane_id() { int l; asm volatile("v_mbcnt_lo_u32_b32 %0, -1, 0\n\tv_mbcnt_hi_u32_b32 %0, -1, %0" : "=v"(l)); return l; }
__device__ __forceinline__ int tid_opaque(int wv) { int t = wv * 64 + lane_id(); asm volatile("" : "+v"(t)); return t; }
#define GLOAD16(DST, PTR, OFF) asm volatile("global_load_dwordx4 %0, %1, off offset:" #OFF : "=&v"(DST) : "v"(PTR) : "memory")
#define GLOAD8(DST, PTR, OFF) asm volatile("global_load_dwordx2 %0, %1, off offset:" #OFF : "=&v"(DST) : "v"(PTR) : "memory")
#define GLOAD4(DST, PTR, OFF) asm volatile("global_load_dword %0, %1, off offset:" #OFF : "=&v"(DST) : "v"(PTR) : "memory")
#define LDS_WAIT() asm volatile("s_waitcnt lgkmcnt(0)" ::: "memory")
#define VM_WAIT() asm volatile("s_waitcnt vmcnt(0)" ::: "memory")

namespace pg8 {
constexpr int BM = 256, BK = 64, HALF = 128, HTB = HALF * BK * 2, STAGE_BYTES = 8 * HTB, NXCD = 8, WGM = 8;
__device__ __forceinline__ int lds_byte(int r, int c) { const int st = (r >> 4) * 2 + (c >> 5), rr = r & 15, cc = c & 31, ob = rr * 64 + cc * 2; return st * 1024 + (ob ^ (((ob >> 9) & 1) << 5)); }
__device__ __forceinline__ void stage_rc(int b, int& R, int& C) { const int st = b / 1024, sb = b % 1024, swz = sb ^ (((sb >> 9) & 1) << 5); R = (st >> 1) * 16 + swz / 64; C = (st & 1) * 32 + (swz % 64) / 2; }
__device__ __forceinline__ int perm32(int rho) { const int n = rho >> 4, i = rho & 15; return 8 * (i >> 2) + 4 * n + (i & 3); }

struct Unit { int pm, pn, e; };
struct Gemm { const bf16* A; const bf16* Bt; int K; size_t bstride; };

__device__ __forceinline__ bool static_tile(int i, int G, int c, int nM, int nN, int& pm, int& pn) {
    const int nwg = nM * nN; const long L = (long)i * G + c; if (L >= nwg) return false;
    int wgid = (int)L; { const int q = nwg / NXCD, r = nwg % NXCD, xcd = wgid % NXCD, off = wgid / NXCD; wgid = (xcd < r ? xcd * (q + 1) : r * (q + 1) + (xcd - r) * q) + off; }
    const int nig = WGM * nN, gid = wgid / nig, fm = gid * WGM, gsz = (nM - fm) < WGM ? (nM - fm) : WGM;
    pm = fm + ((wgid % nig) % gsz); pn = (wgid % nig) / gsz; return true;
}
struct StaticOrder {
    int nM, nN, G, c;
    __device__ __forceinline__ bool next(int i, Unit& u) const { u.e = 0; return static_tile(i, G, c, nM, nN, u.pm, u.pn); }
    __device__ __forceinline__ unsigned arow(const Unit& u, int r) const { return (unsigned)(u.pm * BM + r); }
};
struct RowOrder {
    int pm, nN;
    __device__ __forceinline__ bool next(int i, Unit& u) const { u.e = 0; u.pm = pm; u.pn = i; return i < nN; }
    __device__ __forceinline__ unsigned arow(const Unit& u, int r) const { return (unsigned)(u.pm * BM + r); }
};
struct SingleOrder {
    int pm;
    __device__ __forceinline__ bool next(int i, Unit& u) const { u.e = 0; u.pm = pm; u.pn = 0; return i == 0; }
    __device__ __forceinline__ unsigned arow(const Unit& u, int r) const { return (unsigned)(u.pm * BM + r); }
};
struct MoeOrder {
    int nM, G, c; const LAS int* pst; const unsigned* srt; bool gather;
    __device__ __forceinline__ bool next(int i, Unit& u) const {
        if (!static_tile(i, G, c, nM, 4, u.pm, u.pn)) return false;
        const int x = u.pm * BM, lane = lane_id();
        const int lo = pst[lane], hi = pst[lane + 1];
        const unsigned long long m = __ballot(lo <= x && x < hi);
        u.e = __builtin_amdgcn_readfirstlane(m ? __builtin_ctzll(m) : 0);
        return true;
    }
    __device__ __forceinline__ unsigned arow(const Unit& u, int r) const {
        if (!gather) return (unsigned)(u.pm * BM + r);
        const unsigned a = srt[u.pm * BM + r]; return a == SRT_MARK ? 0u : (a >> 1);
    }
};

template <int ACT> struct EpiBf16 {
    static constexpr int PERM = 2; static constexpr bool AFTER_DRAIN = false;
    bf16* O; int ldc; const float* bias; int split_cols; size_t split_stride; float scale0; int nostore; f32x2* vstat;
    __device__ __forceinline__ void operator()(const f32x4 (&acc)[2][2][4][2], const Unit& u, int wr, int wc, int fr, int fq) const {
        const int row0 = u.pm * BM + wr * 64 + fr; int colt = u.pn * BM; bf16* base = O;
        float sc = 1.f; int tsp = 0; if (split_cols) { const int t = colt / split_cols; tsp = t; base += (size_t)t * split_stride; colt -= t * split_cols; if (t == 0) sc = scale0; }
        const int col0 = colt + wc * 64 + 16 * fq, bcol0 = u.pn * BM + wc * 64 + 16 * fq;
        f32x4 bv[2][2];
#pragma unroll
        for (int bj = 0; bj < 2; ++bj)
#pragma unroll
            for (int n = 0; n < 2; ++n) bv[bj][n] = bias ? *(const f32x4*)(bias + bcol0 + 8 * bj + 4 * n) : (f32x4){0.f, 0.f, 0.f, 0.f};
#pragma unroll
        for (int ai = 0; ai < 2; ++ai)
#pragma unroll
            for (int m = 0; m < 4; ++m) { bf16* rowp = base + (size_t)(row0 + ai * HALF + m * 16) * ldc + col0; float rs_ = 0.f, rq_ = 0.f;
#pragma unroll
                for (int bj = 0; bj < 2; ++bj) { f32x4 v0 = acc[ai][bj][m][0] + bv[bj][0], v1 = acc[ai][bj][m][1] + bv[bj][1];
                    if (ACT == 1 && tsp == 1) {
#pragma unroll
                        for (int j = 0; j < 4; j += 2) { const f32x2 a = gelu_tanh2((f32x2){v0[j], v0[j + 1]}), b = gelu_tanh2((f32x2){v1[j], v1[j + 1]});
                            v0[j] = a.x; v0[j + 1] = a.y; v1[j] = b.x; v1[j + 1] = b.y; rs_ += (a.x + a.y) + (b.x + b.y); rq_ += (a.x * a.x + a.y * a.y) + (b.x * b.x + b.y * b.y); } }
                    v0 = v0 * sc; v1 = v1 * sc; u32x4 w; w.x = cvt_pk_bf16(v0[0], v0[1]); w.y = cvt_pk_bf16(v0[2], v0[3]); w.z = cvt_pk_bf16(v1[0], v1[1]); w.w = cvt_pk_bf16(v1[2], v1[3]);
                    if (!nostore) *(u32x4*)(rowp + 8 * bj) = w; }
                if (ACT == 1 && tsp == 1) { rs_ += __shfl_xor(rs_, 16); rq_ += __shfl_xor(rq_, 16); rs_ += __shfl_xor(rs_, 32); rq_ += __shfl_xor(rq_, 32);
                    if (fq == 0) vstat[(size_t)(row0 + ai * HALF + m * 16) * 48 + (colt >> 8) * 4 + wc] = (f32x2){rs_, rq_}; } }
    }
};
struct EpiNull {
    static constexpr int PERM = 1; static constexpr bool AFTER_DRAIN = false; f32x4* O;
    __device__ __forceinline__ void operator()(const f32x4 (&acc)[2][2][4][2], const Unit& u, int wr, int wc, int fr, int fq) const {
#pragma unroll
        for (int ai = 0; ai < 2; ++ai)
#pragma unroll
            for (int bj = 0; bj < 2; ++bj)
#pragma unroll
                for (int m = 0; m < 4; ++m)
#pragma unroll
                    for (int n = 0; n < 2; ++n) if (u.pm == 0x7fffffff) O[(((ai * 2 + bj) * 4 + m) * 2 + n) * 4096 + fr * 64 + fq * 16 + wc * 4 + wr] = acc[ai][bj][m][n];
    }
};
struct EpiResF32 {
    static constexpr int PERM = 0; static constexpr bool AFTER_DRAIN = false;
    const float* res; float* out; int ldc; float alpha;
    __device__ __forceinline__ void operator()(const f32x4 (&acc)[2][2][4][2], const Unit& u, int wr, int wc, int fr, int fq) const {
        const int col0 = u.pn * BM + wc * 32 + 4 * fq;
#pragma unroll
        for (int ai = 0; ai < 2; ++ai)
#pragma unroll
            for (int m = 0; m < 4; ++m) { const size_t off = (size_t)(u.pm * BM + ai * HALF + wr * 64 + m * 16 + fr) * ldc + col0;
#pragma unroll
                for (int bj = 0; bj < 2; ++bj)
#pragma unroll
                    for (int n = 0; n < 2; ++n) { const f32x4 r = *(const f32x4*)(res + off + bj * HALF + n * 16); *(f32x4*)(out + off + bj * HALF + n * 16) = r * alpha + acc[ai][bj][m][n]; } }
    }
};
struct EpiResBf16 {
    static constexpr int PERM = 2; static constexpr bool AFTER_DRAIN = false;
    const bf16* res; bf16* out; int ldc; float alpha;
    __device__ __forceinline__ void operator()(const f32x4 (&acc)[2][2][4][2], const Unit& u, int wr, int wc, int fr, int fq) const {
        const int col0 = u.pn * BM + wc * 64 + 16 * fq;
        u32x4 rn[2];
        { const size_t off = (size_t)(u.pm * BM + wr * 64 + fr) * ldc + col0; rn[0] = *(const u32x4*)(res + off); rn[1] = *(const u32x4*)(res + off + 8); }
#pragma unroll
        for (int k = 0; k < 8; ++k) { const int ai = k >> 2, m = k & 3; const size_t off = (size_t)(u.pm * BM + ai * HALF + wr * 64 + m * 16 + fr) * ldc + col0;
            u32x4 r[2] = {rn[0], rn[1]};
            if (k + 1 < 8) { const int ai2 = (k + 1) >> 2, m2 = (k + 1) & 3; const size_t off2 = (size_t)(u.pm * BM + ai2 * HALF + wr * 64 + m2 * 16 + fr) * ldc + col0;
                rn[0] = *(const u32x4*)(res + off2); rn[1] = *(const u32x4*)(res + off2 + 8); asm volatile("" : "+v"(rn[0]), "+v"(rn[1])); }
#pragma unroll
            for (int bj = 0; bj < 2; ++bj) { const u32x4 rr = r[bj];
                const f32x4 a0 = acc[ai][bj][m][0], a1 = acc[ai][bj][m][1]; u32x4 w;
                w.x = cvt_pk_bf16(bf_lo(rr.x) * alpha + a0[0], bf_hi(rr.x) * alpha + a0[1]); w.y = cvt_pk_bf16(bf_lo(rr.y) * alpha + a0[2], bf_hi(rr.y) * alpha + a0[3]);
                w.z = cvt_pk_bf16(bf_lo(rr.z) * alpha + a1[0], bf_hi(rr.z) * alpha + a1[1]); w.w = cvt_pk_bf16(bf_lo(rr.w) * alpha + a1[2], bf_hi(rr.w) * alpha + a1[3]);
                *(u32x4*)(out + off + 8 * bj) = w; } }
    }
};
struct EpiRouter {
    static constexpr int PERM = 0; static constexpr bool AFTER_DRAIN = true;
    const float* bg; const float* br;
    __device__ __forceinline__ void fused(f32x4 (&acc)[2][2][4][2], const Unit& u, int wr, int wc, int fr, int fq, lds_u8* lds, int wid, int lane) const {
        LAS float* L = (LAS float*)lds;
        if (wc < 3) {
#pragma unroll
            for (int n = 0; n < 2; ++n) { const int c0 = wc * 32 + 16 * n + 4 * fq;
#pragma unroll
                for (int j = 0; j < 4; ++j) { const int c = c0 + j; if (c < 72) { const float b = c < 8 ? bg[c] : br[c - 8];
#pragma unroll
                    for (int ai = 0; ai < 2; ++ai)
#pragma unroll
                        for (int m = 0; m < 4; ++m) L[(ai * HALF + wr * 64 + m * 16 + fr) * 73 + c] = acc[ai][0][m][n][j] + b; } } } }
    }
};
struct EpiSwiglu {
    static constexpr int PERM = 1; static constexpr bool AFTER_DRAIN = false;
    bf16* O;
    __device__ __forceinline__ void operator()(const f32x4 (&acc)[2][2][4][2], const Unit& u, int wr, int wc, int fr, int fq) const {
        const int col0 = u.pn * 128 + wc * 32 + 8 * fq;
#pragma unroll
        for (int ai = 0; ai < 2; ++ai)
#pragma unroll
            for (int m = 0; m < 4; ++m) { bf16* rowp = O + (size_t)(u.pm * BM + ai * HALF + wr * 64 + m * 16 + fr) * MOEH + col0;
                float o[8];
#pragma unroll
                for (int n = 0; n < 2; ++n)
#pragma unroll
                    for (int j = 0; j < 4; ++j) o[4 * n + j] = silu_f(acc[ai][0][m][n][j]) * acc[ai][1][m][n][j];
                u32x4 w; w.x = cvt_pk_bf16(o[0], o[1]); w.y = cvt_pk_bf16(o[2], o[3]); w.z = cvt_pk_bf16(o[4], o[5]); w.w = cvt_pk_bf16(o[6], o[7]);
                *(u32x4*)rowp = w; }
    }
};
struct EpiScatter {
    static constexpr int PERM = 2; static constexpr bool AFTER_DRAIN = false;
    unsigned char* Y; const unsigned* srt; const float* gate;
    __device__ __forceinline__ void operator()(const f32x4 (&acc)[2][2][4][2], const Unit& u, int wr, int wc, int fr, int fq) const {
        const int col0 = u.pn * BM + wc * 64 + 16 * fq;
        unsigned a8[8]; float g8[8];
#pragma unroll
        for (int k = 0; k < 8; ++k) a8[k] = srt[u.pm * BM + (k >> 2) * HALF + wr * 64 + (k & 3) * 16 + fr];
#pragma unroll
        for (int k = 0; k < 8; ++k) g8[k] = gate[a8[k] == SRT_MARK ? 0u : a8[k]] * YSCALE;
#pragma unroll
        for (int k = 0; k < 8; ++k) { const int ai = k >> 2, m = k & 3; const unsigned a = a8[k];
            if (a != SRT_MARK) { const float gt = g8[k];
                const f32x4 p0 = acc[ai][0][m][0] * gt, p1 = acc[ai][0][m][1] * gt, p2 = acc[ai][1][m][0] * gt, p3 = acc[ai][1][m][1] * gt;
                u32x4 w; w.x = pk4_fp8(p0[0], p0[1], p0[2], p0[3]); w.y = pk4_fp8(p1[0], p1[1], p1[2], p1[3]); w.z = pk4_fp8(p2[0], p2[1], p2[2], p2[3]); w.w = pk4_fp8(p3[0], p3[1], p3[2], p3[3]);
                *(u32x4*)(Y + (size_t)a * D + col0) = w; } }
    }
};
template <class Epi, class Sched, bool ALIGN_EPI, bool GATHER>
__device__ __forceinline__ void gemm_phase(lds_u8* lds, const Gemm g, const Sched& S, const Epi& E, int wv) {
    const int tid = tid_opaque(wv), wid = __builtin_amdgcn_readfirstlane(tid >> 6), lane = tid & 63, wr = wid >> 2, wc = wid & 3, fr = lane & 15, fq = lane >> 4;
    const int K = g.K, nt = K / BK;
    unsigned voffB[2], voffA[2]; int Rl[2], Cl[2];
#pragma unroll
    for (int i = 0; i < 2; ++i) { int R, C; stage_rc(tid * 16 + i * 8192, R, C);
        const int Rb = (int)Epi::PERM == 2 ? (64 * (R >> 5) + 16 * ((R >> 2) & 3) + 4 * ((R >> 4) & 1) + (R & 3)) : ((int)Epi::PERM == 1 ? ((R & ~31) + perm32(R & 31)) : R);
        Rl[i] = R; Cl[i] = C; voffA[i] = (unsigned)(R * K + C) * 2u; voffB[i] = (unsigned)(Rb * K + C) * 2u; }
    const size_t kstep = (size_t)(BK * 2);
    const size_t hstep = (size_t)HALF * K * 2;
    const size_t hstepB = (size_t)((int)Epi::PERM == 2 ? 8 : HALF) * K * 2;
    const size_t tstep = 2 * hstep;
    const unsigned ldsw = (unsigned)wid * 1024u;
    const int aoff = lds_byte(wr * 64 + fr, fq * 8), boff = lds_byte(wc * 32 + fr, fq * 8);
    const char* const Ab = (const char*)g.A;
#define PG8_SA(b, h) (((b) * 2 + (h)) * HTB)
#define PG8_SB(b, h) ((4 + (b) * 2 + (h)) * HTB)
#define PG8_STAGE_B(bufoff, gbase) do { _Pragma("unroll") for (int _i = 0; _i < 2; ++_i) \
        __builtin_amdgcn_global_load_lds((const unsigned*)((const char*)(gbase) + voffB[_i]), (LAS unsigned*)(lds + (bufoff) + ldsw + _i * 8192), 16, 0, 0); } while (0)
#define PG8_STAGE_A(bufoff, kb, ub, vo, h) do { _Pragma("unroll") for (int _i = 0; _i < 2; ++_i) { \
        const char* _src = GATHER ? (Ab + (kb) + (vo)[h][_i]) : ((ub) + (kb) + (size_t)(h) * hstep + voffA[_i]); \
        __builtin_amdgcn_global_load_lds((const unsigned*)_src, (LAS unsigned*)(lds + (bufoff) + ldsw + _i * 8192), 16, 0, 0); } } while (0)
#define PG8_LDA(dst, b, h) do { _Pragma("unroll") for (int m = 0; m < 4; ++m) _Pragma("unroll") for (int k = 0; k < 2; ++k) dst[m][k] = *(const LAS bf16x8*)(lds + PG8_SA(b, h) + aoff + m * 2048 + k * 1024); } while (0)
#define PG8_LDB(dst, b, h) do { _Pragma("unroll") for (int n = 0; n < 2; ++n) _Pragma("unroll") for (int k = 0; k < 2; ++k) dst[n][k] = *(const LAS bf16x8*)(lds + PG8_SB(b, h) + boff + n * 2048 + k * 1024); } while (0)
#define PG8_MMA(ai, bj, At, Bt) do { __builtin_amdgcn_s_setprio(1); _Pragma("unroll") for (int m = 0; m < 4; ++m) _Pragma("unroll") for (int n = 0; n < 2; ++n) _Pragma("unroll") for (int k = 0; k < 2; ++k) \
        acc[ai][bj][m][n] = __builtin_amdgcn_mfma_f32_16x16x32_bf16(Bt[n][k], At[m][k], acc[ai][bj][m][n], 0, 0, 0); __builtin_amdgcn_s_setprio(0); } while (0)
#define PG8_WAIT_V(n) asm volatile("s_waitcnt vmcnt(" #n ")" ::: "memory")
#define PG8_WAIT_L(n) asm volatile("s_waitcnt lgkmcnt(" #n ")" ::: "memory")
#define PG8_BAR __builtin_amdgcn_s_barrier()
#define PG8_SCHED __builtin_amdgcn_sched_barrier(0)
#define PG8_SETVO(vo, u) do { if constexpr (GATHER) { _Pragma("unroll") for (int _h = 0; _h < 2; ++_h) _Pragma("unroll") for (int _i = 0; _i < 2; ++_i) \
        (vo)[_h][_i] = (S.arow((u), _h * HALF + Rl[_i]) * (unsigned)K + (unsigned)Cl[_i]) * 2u; \
        asm volatile("" : "+v"((vo)[0][0]), "+v"((vo)[0][1]), "+v"((vo)[1][0]), "+v"((vo)[1][1])); } } while (0)
    Unit cur, nxt; int ui = 0;
    if (!S.next(0, cur)) return;
    unsigned voC[2][2], voN[2][2];
#pragma unroll
    for (int h = 0; h < 2; ++h)
#pragma unroll
        for (int i = 0; i < 2; ++i) { voC[h][i] = 0u; voN[h][i] = 0u; }
    PG8_SETVO(voC, cur);
    const char* cA = GATHER ? Ab : Ab + (size_t)cur.pm * tstep;
    f32x4 acc[2][2][4][2];
#pragma unroll
    for (int a = 0; a < 2; ++a)
#pragma unroll
        for (int b = 0; b < 2; ++b)
#pragma unroll
            for (int m = 0; m < 4; ++m)
#pragma unroll
                for (int n = 0; n < 2; ++n) acc[a][b][m][n] = (f32x4){0.f, 0.f, 0.f, 0.f};
    bf16x8 At[4][2], B0[2][2], B1[2][2];
    const char* cB = (const char*)g.Bt + (size_t)cur.e * g.bstride + (size_t)cur.pn * tstep;
    PG8_STAGE_B(PG8_SB(0, 0), cB); PG8_STAGE_B(PG8_SB(0, 1), cB + hstepB); PG8_STAGE_A(PG8_SA(0, 0), 0, cA, voC, 0); PG8_STAGE_A(PG8_SA(0, 1), 0, cA, voC, 1);
    if (wr == 1) PG8_BAR;
    PG8_WAIT_V(2); PG8_BAR;
    PG8_STAGE_B(PG8_SB(1, 0), cB + kstep); PG8_STAGE_A(PG8_SA(1, 0), kstep, cA, voC, 0); PG8_STAGE_B(PG8_SB(1, 1), cB + hstepB + kstep);
    PG8_WAIT_V(6); PG8_BAR;
    for (;;) {
        const bool has_next = S.next(ui + 1, nxt);
        if (has_next) { PG8_SETVO(voN, nxt); }
        else {
#pragma unroll
            for (int h = 0; h < 2; ++h)
#pragma unroll
                for (int i = 0; i < 2; ++i) voN[h][i] = voC[h][i]; }
        const char* nB = has_next ? (const char*)g.Bt + (size_t)nxt.e * g.bstride + (size_t)nxt.pn * tstep : cB;
        const char* nA = (has_next && !GATHER) ? Ab + (size_t)nxt.pm * tstep : cA;
        for (int t = 0; t < nt; t += 2) {
            const bool last = (t == nt - 2);
            const size_t k1 = (size_t)(t + 1) * kstep;
            const size_t k2 = last ? 0 : (size_t)(t + 2) * kstep, k3 = k2 + kstep; const char* u2 = last ? nA : cA;
            const char* b2 = last ? nB : cB + (size_t)(t + 2) * kstep;
            const char* b3 = b2 + kstep;
            unsigned vo2[2][2];
#pragma unroll
            for (int h = 0; h < 2; ++h)
#pragma unroll
                for (int i = 0; i < 2; ++i) vo2[h][i] = last ? voN[h][i] : voC[h][i];
            PG8_LDB(B0, 0, 0); PG8_LDB(B1, 0, 1); PG8_SCHED; PG8_LDA(At, 0, 0); PG8_STAGE_A(PG8_SA(1, 1), k1, cA, voC, 1);
            PG8_WAIT_V(8); PG8_WAIT_L(0); PG8_BAR; PG8_MMA(0, 0, At, B0); PG8_MMA(0, 1, At, B1); PG8_BAR; PG8_SCHED;
            PG8_LDA(At, 0, 1); PG8_STAGE_B(PG8_SB(0, 0), b2); PG8_STAGE_B(PG8_SB(0, 1), b2 + hstepB); PG8_STAGE_A(PG8_SA(0, 0), k2, u2, vo2, 0);
            PG8_WAIT_V(8); PG8_WAIT_L(0); PG8_BAR; PG8_MMA(1, 0, At, B0); PG8_MMA(1, 1, At, B1); PG8_BAR; PG8_SCHED;
            PG8_LDB(B0, 1, 0); PG8_LDB(B1, 1, 1); PG8_SCHED; PG8_LDA(At, 1, 0); PG8_STAGE_A(PG8_SA(0, 1), k2, u2, vo2, 1);
            PG8_WAIT_V(8); PG8_WAIT_L(0); PG8_BAR; PG8_MMA(0, 0, At, B0); PG8_MMA(0, 1, At, B1); PG8_BAR; PG8_SCHED;
            PG8_LDA(At, 1, 1); PG8_STAGE_B(PG8_SB(1, 0), b3); PG8_STAGE_B(PG8_SB(1, 1), b3 + hstepB); PG8_STAGE_A(PG8_SA(1, 0), k3, u2, vo2, 0);
            PG8_WAIT_V(8); PG8_WAIT_L(0); PG8_BAR; PG8_MMA(1, 0, At, B0); PG8_MMA(1, 1, At, B1); PG8_BAR; PG8_SCHED;
        }
        if constexpr (ALIGN_EPI) { if (wr == 0) PG8_BAR; }
        if constexpr (!Epi::AFTER_DRAIN) { E(acc, cur, wr, wc, fr, fq); }
        if (!has_next) break;
#pragma unroll
        for (int a = 0; a < 2; ++a)
#pragma unroll
            for (int b = 0; b < 2; ++b)
#pragma unroll
                for (int m = 0; m < 4; ++m)
#pragma unroll
                    for (int n = 0; n < 2; ++n) acc[a][b][m][n] = (f32x4){0.f, 0.f, 0.f, 0.f};
        cur = nxt; cB = nB; cA = nA; ++ui;
#pragma unroll
        for (int h = 0; h < 2; ++h)
#pragma unroll
            for (int i = 0; i < 2; ++i) voC[h][i] = voN[h][i];
        if constexpr (ALIGN_EPI) { if (wr == 1) PG8_BAR; }
    }
    PG8_WAIT_V(0);
    if constexpr (!ALIGN_EPI) { if (wr == 0) PG8_BAR; }
    PG8_BAR;
    if constexpr (Epi::AFTER_DRAIN) { E.fused(acc, cur, wr, wc, fr, fq, lds, wid, lane); }
#undef PG8_SA
#undef PG8_SB
#undef PG8_STAGE_A
#undef PG8_STAGE_B
#undef PG8_LDA
#undef PG8_LDB
#undef PG8_MMA
#undef PG8_WAIT_V
#undef PG8_WAIT_L
#undef PG8_BAR
#undef PG8_SCHED
#undef PG8_SETVO
}
}

namespace da {
constexpr int QBLK = 32, KVBLK = 64, LDQ = NQKV;
constexpr int SHM_V = KVBLK * 128 * 2, SHM_K = KVBLK * 64 * 2;
constexpr int L_V = 0, L_K = 2 * SHM_V, L_WS = L_K + 2 * SHM_K, L_TAB = L_WS + NWAVES * 64 * 4, L_STASH = L_TAB + 640 * 4, L_ENDA = L_STASH + NWAVES * 32 * 64 * 4;
static_assert(L_ENDA <= RING_BYTES && (L_STASH % 16) == 0, "attention LDS map");
constexpr float THR = 8.f;
#define SBAR() __builtin_amdgcn_sched_barrier(0)
#define KSWZ64(row, colB) ((row) * 128 + ((colB) ^ ((((row) >> 1) & 7) << 4)))
__device__ __forceinline__ int crow(int r, int hi) { return (r & 3) + 8 * (r >> 2) + 4 * hi; }

__device__ __forceinline__ float rowmax32(const f32x16& p0, const f32x16& p1) {
    float a = fmaxf(fmaxf(p0[0], p0[1]), p1[0]), b = fmaxf(fmaxf(p0[2], p0[3]), p1[1]); a = fmaxf(fmaxf(a, p1[2]), p1[3]);
#pragma unroll
    for (int r = 4; r < 16; r += 4) { a = fmaxf(fmaxf(a, p0[r]), p0[r + 1]); b = fmaxf(fmaxf(b, p0[r + 2]), p0[r + 3]); a = fmaxf(fmaxf(a, p1[r]), p1[r + 1]); b = fmaxf(fmaxf(b, p1[r + 2]), p1[r + 3]); }
    const float m = fmaxf(a, b);
    auto rr = __builtin_amdgcn_permlane32_swap(__float_as_uint(m), __float_as_uint(m), false, false);
    return fmaxf(__uint_as_float(rr[0]), __uint_as_float(rr[1]));
}
__device__ __forceinline__ void packP(const f32x16& p0, const f32x16& p1, bf16x8& pa0, bf16x8& pa1, bf16x8& pa2, bf16x8& pa3) {
#define PK4(P, BASE, OUT) do { u32x4 w = {cvt_pk_bf16(P[BASE + 0], P[BASE + 1]), cvt_pk_bf16(P[BASE + 2], P[BASE + 3]), cvt_pk_bf16(P[BASE + 4], P[BASE + 5]), cvt_pk_bf16(P[BASE + 6], P[BASE + 7])}; \
    OUT = __builtin_bit_cast(bf16x8, w); } while (0)
    PK4(p0, 0, pa0); PK4(p0, 8, pa1); PK4(p1, 0, pa2); PK4(p1, 8, pa3);
#undef PK4
}
__device__ __forceinline__ void kload8(bf16x8 (&kf)[8], const LAS char* Ks, int r32, int hi) {
#pragma unroll
    for (int d0 = 0; d0 < 4; ++d0) { const int cb = (d0 * 16 + hi * 8) * 2;
        kf[2 * d0] = *(const LAS bf16x8*)(Ks + KSWZ64(r32, cb)); kf[2 * d0 + 1] = *(const LAS bf16x8*)(Ks + KSWZ64(32 + r32, cb)); }
}
__device__ __forceinline__ void qkt_mm(f32x16& p0, f32x16& p1, const bf16x8 (&kf)[8], const bf16x8* qr, const f32x16& cinit) {
    p0 = __builtin_amdgcn_mfma_f32_32x32x16_bf16(kf[0], qr[0], cinit, 0, 0, 0); p1 = __builtin_amdgcn_mfma_f32_32x32x16_bf16(kf[1], qr[0], cinit, 0, 0, 0);
#pragma unroll
    for (int d0 = 1; d0 < 4; ++d0) { p0 = __builtin_amdgcn_mfma_f32_32x32x16_bf16(kf[2 * d0], qr[d0], p0, 0, 0, 0); p1 = __builtin_amdgcn_mfma_f32_32x32x16_bf16(kf[2 * d0 + 1], qr[d0], p1, 0, 0, 0); }
}
__device__ __forceinline__ void qkt(f32x16& p0, f32x16& p1, const LAS char* Ks, const bf16x8* qr, const f32x16& cinit, int r32, int hi) {
    bf16x8 kf[8]; kload8(kf, Ks, r32, hi);
    asm volatile("s_waitcnt lgkmcnt(0)" ::: "memory"); SBAR();
    qkt_mm(p0, p1, kf, qr, cinit);
}
__device__ __forceinline__ int v_st(int k, int c) { const int kk = (k & ~0xC) | ((k & 4) << 1) | ((k & 8) >> 1); return ((kk >> 3) * 4 + (c >> 5)) * 512 + ((kk & 7) * 32 + (c & 31)) * 2; }
__device__ __forceinline__ int v_rd_base(int lane) { return ((lane & 3) << 3) | (((lane >> 2) & 3) << 6) | (((lane >> 4) & 1) << 5) | (((lane >> 5) & 1) << 8); }
constexpr int v_rd_off(int d0, int ks, int half) { return d0 * 512 + ks * 4096 + half * 2048; }
template <int OFF> __device__ __forceinline__ s16x4 tr_read(int vb) {
    s16x4 r; asm volatile("ds_read_b64_tr_b16 %0, %1 offset:%2" : "=&v"(r) : "v"(vb), "i"(OFF) : "memory"); return r;
}
template <int D0> __device__ __forceinline__ void pv_one(f32x16& od, int vb, bf16x8 pa0, bf16x8 pa1, bf16x8 pa2, bf16x8 pa3) {
#define PK(L, H) (bf16x8){L[0], L[1], L[2], L[3], H[0], H[1], H[2], H[3]}
    { const s16x4 l0 = tr_read<v_rd_off(D0, 0, 0)>(vb), h0 = tr_read<v_rd_off(D0, 0, 1)>(vb), l1 = tr_read<v_rd_off(D0, 1, 0)>(vb), h1 = tr_read<v_rd_off(D0, 1, 1)>(vb);
      asm volatile("s_waitcnt lgkmcnt(0)" ::: "memory"); SBAR();
      od = __builtin_amdgcn_mfma_f32_32x32x16_bf16(pa0, PK(l0, h0), od, 0, 0, 0);
      od = __builtin_amdgcn_mfma_f32_32x32x16_bf16(pa1, PK(l1, h1), od, 0, 0, 0); }
    { const s16x4 l2 = tr_read<v_rd_off(D0, 2, 0)>(vb), h2 = tr_read<v_rd_off(D0, 2, 1)>(vb), l3 = tr_read<v_rd_off(D0, 3, 0)>(vb), h3 = tr_read<v_rd_off(D0, 3, 1)>(vb);
      asm volatile("s_waitcnt lgkmcnt(0)" ::: "memory"); SBAR();
      od = __builtin_amdgcn_mfma_f32_32x32x16_bf16(pa2, PK(l2, h2), od, 0, 0, 0);
      od = __builtin_amdgcn_mfma_f32_32x32x16_bf16(pa3, PK(l3, h3), od, 0, 0, 0); }
#undef PK
}
__device__ __forceinline__ void pv_d0(f32x16* o, int vb, bf16x8 pa0, bf16x8 pa1, bf16x8 pa2, bf16x8 pa3) {
    pv_one<0>(o[0], vb, pa0, pa1, pa2, pa3); pv_one<1>(o[1], vb, pa0, pa1, pa2, pa3); pv_one<2>(o[2], vb, pa0, pa1, pa2, pa3); pv_one<3>(o[3], vb, pa0, pa1, pa2, pa3);
}
__device__ __forceinline__ void biasmask(f32x16& p0, f32x16& p1, int base, int hi, const LAS float* tab) {
    const LAS float* tp = tab + (base + 256 - 4 * hi - 59);
    const int bl = base - 4 * hi;
#pragma unroll
    for (int q = 0; q < 4; ++q) {
        float b0[4], b1[4];
#pragma unroll
        for (int i = 0; i < 4; ++i) { b0[i] = tp[59 - (i + 8 * q)]; b1[i] = tp[59 - 32 - (i + 8 * q)]; }
        asm volatile("s_waitcnt lgkmcnt(0)" ::: "memory"); SBAR();
#pragma unroll
        for (int i = 0; i < 4; ++i) { const int kk = i + 8 * q, r = 4 * q + i;
            const float a0 = p0[r] + b0[i], a1 = p1[r] + b1[i];
            p0[r] = (kk > bl) ? -INFINITY : a0;
            p1[r] = (kk + 32 > bl) ? -INFINITY : a1; }
        SBAR();
    }
}

__device__ __forceinline__ void flash_pass(f32x16 (&o)[4], const bf16* __restrict__ Qw, const bf16* __restrict__ Kh, const bf16* __restrict__ Vh,
                                           int NT, int qabs, lds_u8* lds, int wv) {
    const int tid = tid_opaque(wv), wid = wv, lane = tid & 63, r32 = lane & 31, hi = lane >> 5;
    LAS char* V_lds = (LAS char*)(lds + L_V); LAS char* K_lds = (LAS char*)(lds + L_K);
    LAS float* al_l = (LAS float*)(lds + L_WS) + wid * 64;
    const LAS float* tab = (const LAS float*)(lds + L_TAB);
    unsigned koff, voff0, voff1;
    { const int g = wid * 64 + lane, row = g >> 3; koff = (unsigned)(row * LDQ + (((g & 7) ^ ((row >> 1) & 7)) * 8)) * 2u; }
    { const int g = (wid * 2) * 64 + lane, st = g >> 5, k = ((st >> 2) << 3) | ((g >> 2) & 7), c = (st & 3) * 32 + (g & 3) * 8; voff0 = (unsigned)(k * LDQ + c) * 2u; }
    { const int g = (wid * 2 + 1) * 64 + lane, st = g >> 5, k = ((st >> 2) << 3) | ((g >> 2) & 7), c = (st & 3) * 32 + (g & 3) * 8; voff1 = (unsigned)(k * LDQ + c) * 2u; }
#define GLDS16(src, dst) __builtin_amdgcn_global_load_lds((const unsigned*)(src), (LAS unsigned*)(dst), 16, 0, 0)
#define DMA_K(t, slot) GLDS16((const char*)Kh + (size_t)(t) * (KVBLK * LDQ * 2) + koff, K_lds + (slot) * SHM_K + wid * 1024)
#define DMA_V(t, slot) do { const char* vt_ = (const char*)Vh + (size_t)(t) * (KVBLK * LDQ * 2); \
    GLDS16(vt_ + voff0, V_lds + (slot) * SHM_V + wid * 2048); GLDS16(vt_ + voff1, V_lds + (slot) * SHM_V + wid * 2048 + 1024); } while (0)
#define WAIT_BAR() asm volatile("s_waitcnt vmcnt(0) lgkmcnt(0)\n\ts_barrier" ::: "memory")
    DMA_K(0, 0); DMA_V(0, 0); DMA_K(1, 1);
    bf16x8 qr[4];
#pragma unroll
    for (int d0 = 0; d0 < 4; ++d0) { o[d0] = f32x16{}; qr[d0] = *(const bf16x8*)(Qw + d0 * 16); }
    float z0_ = 0.f; asm volatile("" : "+v"(z0_));
    f32x16 negm, lacc = f32x16{};
#pragma unroll
    for (int r = 0; r < 16; ++r) negm[r] = z0_;
    asm volatile("" : "+v"(negm));
    float mhat = 0.f;
    const u32x4 onesw = {0x3F803F80u, 0x3F803F80u, 0x3F803F80u, 0x3F803F80u}; const bf16x8 ones = __builtin_bit_cast(bf16x8, onesw);
    const int vb0 = (int)(uintptr_t)V_lds + v_rd_base(lane);
    const int jlast = NT - 4 + (wid >> 1);
    f32x16 pA0, pA1, pB0, pB1; bf16x8 pa0, pa1, pa2, pa3; bool resc = false;
#define BMASK(P0, P1, j) do { if ((j) >= jlast - 2) biasmask(P0, P1, qabs - 64 * (j), hi, tab); } while (0)
#define DECIDE_A(C0, C1, FIRST) do { const float rm = rowmax32(C0, C1); resc = false; \
    if ((FIRST) || __any(rm > THR)) { const float dl = (FIRST) ? rm : fmaxf(rm, 0.f); mhat += dl; \
        _Pragma("unroll") for (int r = 0; r < 16; ++r) { C0[r] -= dl; C1[r] -= dl; } \
        _Pragma("unroll") for (int r = 0; r < 16; ++r) negm[r] = -mhat; asm volatile("" : "+v"(negm)); \
        if (!(FIRST)) { const float f = __builtin_amdgcn_exp2f(-dl); if (hi == 0) al_l[r32] = f; resc = true; } } } while (0)
#define EXPALL(C0, C1) do { _Pragma("unroll") for (int r = 0; r < 16; ++r) { C0[r] = __builtin_amdgcn_exp2f(C0[r]); C1[r] = __builtin_amdgcn_exp2f(C1[r]); } } while (0)
#define RESC() do { if (resc) { asm volatile("s_waitcnt lgkmcnt(0)" ::: "memory"); \
    _Pragma("unroll") for (int r = 0; r < 16; ++r) { const float f = al_l[crow(r, hi)]; o[0][r] *= f; o[1][r] *= f; o[2][r] *= f; o[3][r] *= f; lacc[r] *= f; } resc = false; } } while (0)
#define LSUM() do { lacc = __builtin_amdgcn_mfma_f32_32x32x16_bf16(pa0, ones, lacc, 0, 0, 0); lacc = __builtin_amdgcn_mfma_f32_32x32x16_bf16(pa1, ones, lacc, 0, 0, 0); \
    lacc = __builtin_amdgcn_mfma_f32_32x32x16_bf16(pa2, ones, lacc, 0, 0, 0); lacc = __builtin_amdgcn_mfma_f32_32x32x16_bf16(pa3, ones, lacc, 0, 0, 0); } while (0)
#define MF32(a, b, c) __builtin_amdgcn_mfma_f32_32x32x16_bf16(a, b, c, 0, 0, 0)
#define PKV(L, H) (bf16x8){L[0], L[1], L[2], L[3], H[0], H[1], H[2], H[3]}
#define RD(G) const s16x4 la##G = tr_read<v_rd_off((G) >> 1, 2 * ((G) & 1), 0)>(vb_), ha##G = tr_read<v_rd_off((G) >> 1, 2 * ((G) & 1), 1)>(vb_), \
                          lb##G = tr_read<v_rd_off((G) >> 1, 2 * ((G) & 1) + 1, 0)>(vb_), hb##G = tr_read<v_rd_off((G) >> 1, 2 * ((G) & 1) + 1, 1)>(vb_)
#define MM(G, PA, PB) asm volatile("s_waitcnt lgkmcnt(0)" ::: "memory"); SBAR(); \
    o[(G) >> 1] = MF32(PA, PKV(la##G, ha##G), o[(G) >> 1]); o[(G) >> 1] = MF32(PB, PKV(lb##G, hb##G), o[(G) >> 1])
#define EX4(C, B) C[B] = __builtin_amdgcn_exp2f(C[B]); C[B + 1] = __builtin_amdgcn_exp2f(C[B + 1]); C[B + 2] = __builtin_amdgcn_exp2f(C[B + 2]); C[B + 3] = __builtin_amdgcn_exp2f(C[B + 3]); \
    asm volatile("" : "+v"(C)); SBAR()
#define STEP(Cn0, Cn1, Pp0, Pp1, s, KS, VS) do { SBAR(); \
    bf16x8 kf_[8]; kload8(kf_, K_lds + (KS) * SHM_K, r32, hi); SBAR();        \
    packP(Pp0, Pp1, pa0, pa1, pa2, pa3); SBAR(); \
    asm volatile("s_waitcnt lgkmcnt(0)" ::: "memory"); SBAR(); qkt_mm(Cn0, Cn1, kf_, qr, negm); SBAR(); \
    const int vb_ = vb0 + (VS) * SHM_V; \
    RD(0); SBAR(); \
    BMASK(Cn0, Cn1, s); DECIDE_A(Cn0, Cn1, false); SBAR(); \
    MM(0, pa0, pa1); RD(1); EX4(Cn0, 0); \
    MM(1, pa2, pa3); RD(2); EX4(Cn0, 4); \
    MM(2, pa0, pa1); RD(3); EX4(Cn0, 8); \
    MM(3, pa2, pa3); RD(4); EX4(Cn0, 12); \
    MM(4, pa0, pa1); RD(5); EX4(Cn1, 0); \
    MM(5, pa2, pa3); RD(6); EX4(Cn1, 4); \
    MM(6, pa0, pa1); RD(7); EX4(Cn1, 8); \
    MM(7, pa2, pa3);        EX4(Cn1, 12); \
    LSUM(); \
    WAIT_BAR(); \
    if ((s) + 2 < NT) DMA_K((s) + 2, KS); if ((s) + 1 < NT) DMA_V((s) + 1, VS); \
    RESC(); } while (0)
    WAIT_BAR();
    qkt(pA0, pA1, K_lds, qr, negm, r32, hi); BMASK(pA0, pA1, 0); DECIDE_A(pA0, pA1, true); EXPALL(pA0, pA1);
    WAIT_BAR();
    DMA_K(2, 0); DMA_V(1, 1);
    const int jl2 = jlast | 1;
    STEP(pB0, pB1, pA0, pA1, 1, 1, 0);
    int s = 2;
    for (; s < jl2; s += 2) {
        STEP(pA0, pA1, pB0, pB1, s, 0, 1);
        STEP(pB0, pB1, pA0, pA1, s + 1, 1, 0);
    }
    packP(pB0, pB1, pa0, pa1, pa2, pa3); pv_d0(o, vb0 + SHM_V, pa0, pa1, pa2, pa3); LSUM();
    for (; s < NT; ++s) { WAIT_BAR(); if (s + 2 < NT) DMA_K(s + 2, s & 1); if (s + 1 < NT) DMA_V(s + 1, (s + 1) & 1); }
#pragma unroll
    for (int r = 0; r < 16; ++r) { const float rl = __builtin_amdgcn_rcpf(lacc[r]);
#pragma unroll
        for (int d = 0; d < 4; ++d) o[d][r] *= rl; }
    WAIT_BAR();
#undef GLDS16
#undef DMA_K
#undef DMA_V
#undef WAIT_BAR
#undef BMASK
#undef DECIDE_A
#undef EXPALL
#undef MF32
#undef PKV
#undef RD
#undef MM
#undef EX4
#undef RESC
#undef STEP
#undef LSUM
}

__device__ __forceinline__ void attn_unit(int b, int h, int qt, const bf16* qkv, bf16* ob, const float* dtab, const float* subg, float lam, lds_u8* lds, int wv) {
    const int tid = tid_opaque(wv), wid = tid >> 6, lane = tid & 63, r32 = lane & 31, hi = lane >> 5;
    LAS float* tab = (LAS float*)(lds + L_TAB);
    for (int i = tid; i < 640; i += NTHREADS) { const int d = i - 256; tab[i] = (d >= 0 && d < 128) ? dtab[h * 128 + d] : 0.f; }
    __syncthreads();
    const long rowbase = (long)b * SEQ; const int q0 = qt * 256; const int NT = 4 * qt + 4;
    const int qabs = q0 + wid * QBLK + r32;
    LAS unsigned* stash = (LAS unsigned*)(lds + L_STASH) + wid * (32 * 64) + lane;
    f32x16 o[4];
    { const bf16* Qw = qkv + (rowbase + qabs) * LDQ + h * 128 + hi * 8;
      const bf16* Kh = qkv + rowbase * LDQ + 1024 + h * 128;
      const bf16* Vh = qkv + rowbase * LDQ + 2048 + h * 128;
      flash_pass(o, Qw, Kh, Vh, NT, qabs, lds, wv);
#pragma unroll
      for (int r = 0; r < 16; ++r) { stash[(2 * r) * 64] = cvt_pk_bf16(o[0][r], o[1][r]); stash[(2 * r + 1) * 64] = cvt_pk_bf16(o[2][r], o[3][r]); } }
    { const bf16* Qw = qkv + (rowbase + qabs) * LDQ + h * 128 + 64 + hi * 8;
      const bf16* Kh = qkv + rowbase * LDQ + 1024 + h * 128 + 64;
      const bf16* Vh = qkv + rowbase * LDQ + 2048 + h * 128;
      flash_pass(o, Qw, Kh, Vh, NT, qabs, lds, wv); }
    LDS_WAIT();
    unsigned sw[32];
#pragma unroll
    for (int i = 0; i < 32; ++i) sw[i] = stash[i * 64];
    float gsc[4];
#pragma unroll
    for (int d = 0; d < 4; ++d) gsc[d] = subg[32 * d + r32] * 0.8f;
    LDS_WAIT();
    LAS bf16* stg = (LAS bf16*)((LAS unsigned*)(lds + L_STASH) + wid * (32 * 64));
#pragma unroll
    for (int r = 0; r < 16; ++r) {
        const unsigned w0 = sw[2 * r], w1 = sw[2 * r + 1];
        const float v0 = bf_lo(w0) - lam * o[0][r], v1 = bf_hi(w0) - lam * o[1][r], v2 = bf_lo(w1) - lam * o[2][r], v3 = bf_hi(w1) - lam * o[3][r];
        float ss = (v0 * v0 + v1 * v1) + (v2 * v2 + v3 * v3);
        ss += __shfl_xor(ss, 1); ss += __shfl_xor(ss, 2); ss += __shfl_xor(ss, 4); ss += __shfl_xor(ss, 8); ss += __shfl_xor(ss, 16);
        const float rs = 1.0f / sqrtf(ss * (1.0f / 128.0f) + LN_EPS);
        LAS bf16* sp = stg + crow(r, hi) * 128 + r32;
        sp[0] = (bf16)(cvt_pk_bf16(v0 * rs * gsc[0], 0.f) & 0xffffu); sp[32] = (bf16)(cvt_pk_bf16(v1 * rs * gsc[1], 0.f) & 0xffffu);
        sp[64] = (bf16)(cvt_pk_bf16(v2 * rs * gsc[2], 0.f) & 0xffffu); sp[96] = (bf16)(cvt_pk_bf16(v3 * rs * gsc[3], 0.f) & 0xffffu);
    }
    LDS_WAIT();
    { bf16* obase = ob + (rowbase + q0 + wid * QBLK) * D + h * 128;
#pragma unroll
      for (int i = 0; i < 8; ++i) { const int row = i * 4 + (lane >> 4), ch = lane & 15;
          const u32x4 v = *(const LAS u32x4*)(stg + row * 128 + ch * 8); *(u32x4*)(obase + (size_t)row * D + ch * 8) = v; } }
    __syncthreads();
}
}

namespace sg {
constexpr int L_VT = 0;
constexpr int L_ST = 65536;
constexpr int L_STG = 66560;
constexpr int STG_LD = 68, STG_BYTES = 32 * STG_LD * 4;
constexpr int L_PRM = L_STG + NWAVES * STG_BYTES;
static_assert(L_PRM + 2048 <= LDSCTL_OFF, "spatial LDS map");
__device__ __forceinline__ void chunk_unit(int ch, bf16* U, const bf16* V, const f32x2* vstat, const float* lng, const float* lnb, const bf16* wtril, const float* bs, lds_u8* lds, int wv) {
    const int tid = tid_opaque(wv), wid = tid >> 6, lane = tid & 63, r32 = lane & 31, hi = lane >> 5;
    const long R0 = (long)ch * SGC;
    LAS float* st = (LAS float*)(lds + L_ST);
    if (tid < SGC) { const f32x2* sp = vstat + (size_t)(R0 + tid) * 48; float s_ = 0.f, q_ = 0.f;
#pragma unroll 8
        for (int i = 0; i < 48; ++i) { const f32x2 t = sp[i]; s_ += t.x; q_ += t.y; }
        const float mu = s_ * (1.0f / SGH); const float var = fmaxf(q_ * (1.0f / SGH) - mu * mu, 0.f);
        st[tid * 2] = mu; st[tid * 2 + 1] = 1.0f / sqrtf(var + LN_EPS); }
    __syncthreads();
    const int sr = tid >> 4, sc = (tid & 15) * 8;
    const int rb = wid & 3, chh = wid >> 2;
    LAS float* stg = (LAS float*)(lds + L_STG + wid * STG_BYTES);
    u32x4 vq[4]; f32x4 pq = {0.f, 0.f, 0.f, 0.f};
#define SG_LOADV(SL) do { const int c0_ = (SL) * 128; \
    _Pragma("unroll") for (int i = 0; i < 4; ++i) { const bf16* p_ = V + (R0 + sr + 32 * i) * SGH + c0_ + sc; GLOAD16(vq[i], p_, 0); } } while (0)
#define SG_LOADP(SL) do { if (wid == 0) { const float* pp_ = (lane < 32 ? lng : lnb) + (SL) * 128 + 4 * (lane & 31); GLOAD16(pq, pp_, 0); } } while (0)
#define SG_PUTP(SL) do { if (wid == 0) { *(LAS f32x4*)(lds + L_PRM + ((SL) & 1) * 1024 + (lane >> 5) * 512 + (lane & 31) * 16) = pq; } } while (0)
    bf16x8 wfn[8]; u32x4 uqn[4]; float btn[4];
#define SG_LOADU(SL) do { const int g_ = (SL) / 3, c0_ = (SL) * 128; const bf16* wrow_ = wtril + ((size_t)g_ * 128 + rb * 32 + r32) * 128 + hi * 8; \
    if ((SL) % 3 == 0) { GLOAD16(wfn[0], wrow_, 0); GLOAD16(wfn[1], wrow_, 32); GLOAD16(wfn[2], wrow_, 64); GLOAD16(wfn[3], wrow_, 96); \
      if (rb >= 2) { GLOAD16(wfn[4], wrow_, 128); GLOAD16(wfn[5], wrow_, 160); GLOAD16(wfn[6], wrow_, 192); GLOAD16(wfn[7], wrow_, 224); } }     \
    _Pragma("unroll") for (int i = 0; i < 4; ++i) { const int tr_ = (lane >> 3) + 8 * i, cc_ = (lane & 7) * 8; const int t_ = rb * 32 + tr_; \
        const bf16* pu_ = U + (R0 + t_) * SGH + c0_ + chh * 64 + cc_; const float* pbs_ = bs + g_ * 128 + t_; GLOAD16(uqn[i], pu_, 0); if ((SL) % 3 == 0) GLOAD4(btn[i], pbs_, 0); } } while (0)
#define SG_WAIT(N) do { asm volatile("s_waitcnt vmcnt(" #N ")" : "+v"(vq[0]), "+v"(vq[1]), "+v"(vq[2]), "+v"(vq[3]), "+v"(pq) :: "memory"); \
    asm volatile("" : "+v"(wfn[0]), "+v"(wfn[1]), "+v"(wfn[2]), "+v"(wfn[3]), "+v"(uqn[0]), "+v"(uqn[1]), "+v"(uqn[2]), "+v"(uqn[3]) :: "memory"); \
    asm volatile("" : "+v"(btn[0]), "+v"(btn[1]), "+v"(btn[2]), "+v"(btn[3]) :: "memory"); \
    if (rb >= 2) asm volatile("" : "+v"(wfn[4]), "+v"(wfn[5]), "+v"(wfn[6]), "+v"(wfn[7]) :: "memory"); } while (0)
    bf16x8 wf[8]; float btq[4];
    SG_LOADP(0); SG_WAIT(0); SG_PUTP(0); SG_LOADP(1); SG_WAIT(0); SG_PUTP(1);
    SG_LOADV(0); SG_LOADU(0); SG_WAIT(0);
    LDS_WAIT(); __syncthreads();
#pragma unroll 1
    for (int sl = 0; sl < 24; ++sl) {
        const int c0 = sl * 128; const int buf = sl & 1;
        LAS char* vt = (LAS char*)(lds + L_VT + buf * 32768);
        const LAS float* prm = (const LAS float*)(lds + L_PRM + buf * 1024);
        const f32x4 ga = *(const LAS f32x4*)(prm + sc), gb = *(const LAS f32x4*)(prm + sc + 4), ba = *(const LAS f32x4*)(prm + 128 + sc), bb = *(const LAS f32x4*)(prm + 128 + sc + 4);
#pragma unroll
        for (int i = 0; i < 4; ++i) { const int row = sr + 32 * i; const u32x4 w = vq[i];
            const float rs = st[row * 2 + 1], sh = -st[row * 2] * rs;
            u32x4 o;
#define NRM(X, G, B) (((X) * rs + sh) * (G) + (B))
            o.x = cvt_pk_bf16(NRM(bf_lo(w.x), ga[0], ba[0]), NRM(bf_hi(w.x), ga[1], ba[1]));
            o.y = cvt_pk_bf16(NRM(bf_lo(w.y), ga[2], ba[2]), NRM(bf_hi(w.y), ga[3], ba[3]));
            o.z = cvt_pk_bf16(NRM(bf_lo(w.z), gb[0], bb[0]), NRM(bf_hi(w.z), gb[1], bb[1]));
            o.w = cvt_pk_bf16(NRM(bf_lo(w.w), gb[2], bb[2]), NRM(bf_hi(w.w), gb[3], bb[3]));
#undef NRM
            *(LAS u32x4*)(vt + (row >> 6) * 16384 + da::v_st(row & 63, sc)) = o; }
        u32x4 uq[4];
        if (sl % 3 == 0) {
#pragma unroll
            for (int j = 0; j < 8; ++j) wf[j] = wfn[j];
#pragma unroll
            for (int i = 0; i < 4; ++i) btq[i] = btn[i]; }
#pragma unroll
        for (int i = 0; i < 4; ++i) uq[i] = uqn[i];
        { const int sn = sl + 1 < 24 ? sl + 1 : 23, sp = sl + 2 < 24 ? sl + 2 : 23; SG_LOADV(sn); SG_LOADU(sn); SG_LOADP(sp); }
        __syncthreads();
        f32x16 o0 = f32x16{}, o1 = f32x16{};
        const int vb = (int)(uintptr_t)vt + da::v_rd_base(lane);
        if (chh == 0) { da::pv_one<0>(o0, vb, wf[0], wf[1], wf[2], wf[3]); da::pv_one<1>(o1, vb, wf[0], wf[1], wf[2], wf[3]); }
        else          { da::pv_one<2>(o0, vb, wf[0], wf[1], wf[2], wf[3]); da::pv_one<3>(o1, vb, wf[0], wf[1], wf[2], wf[3]); }
        if (rb >= 2) {
            if (chh == 0) { da::pv_one<0>(o0, vb + 16384, wf[4], wf[5], wf[6], wf[7]); da::pv_one<1>(o1, vb + 16384, wf[4], wf[5], wf[6], wf[7]); }
            else          { da::pv_one<2>(o0, vb + 16384, wf[4], wf[5], wf[6], wf[7]); da::pv_one<3>(o1, vb + 16384, wf[4], wf[5], wf[6], wf[7]); } }
#pragma unroll
        for (int r = 0; r < 16; ++r) { const int tr = da::crow(r, hi); stg[tr * STG_LD + r32] = o0[r]; stg[tr * STG_LD + 32 + r32] = o1[r]; }
        LDS_WAIT();
#pragma unroll
        for (int i = 0; i < 4; ++i) { const int tr = (lane >> 3) + 8 * i, cc = (lane & 7) * 8; const int t = rb * 32 + tr; const float bt = btq[i];
            const f32x4 s0 = *(const LAS f32x4*)(stg + tr * STG_LD + cc), s1 = *(const LAS f32x4*)(stg + tr * STG_LD + cc + 4);
            bf16* up = U + (R0 + t) * SGH + c0 + chh * 64 + cc; const u32x4 uw = uq[i]; u32x4 ow;
            { const f32x2 g0 = gelu_tanh2((f32x2){bf_lo(uw.x), bf_hi(uw.x)}), g1 = gelu_tanh2((f32x2){bf_lo(uw.y), bf_hi(uw.y)}), g2 = gelu_tanh2((f32x2){bf_lo(uw.z), bf_hi(uw.z)}), g3 = gelu_tanh2((f32x2){bf_lo(uw.w), bf_hi(uw.w)});
              ow.x = cvt_pk_bf16(g0.x * (s0[0] + bt), g0.y * (s0[1] + bt)); ow.y = cvt_pk_bf16(g1.x * (s0[2] + bt), g1.y * (s0[3] + bt));
              ow.z = cvt_pk_bf16(g2.x * (s1[0] + bt), g2.y * (s1[1] + bt)); ow.w = cvt_pk_bf16(g3.x * (s1[2] + bt), g3.y * (s1[3] + bt)); }
            *(u32x4*)up = ow; }
        LDS_WAIT();
        SG_WAIT(4);
        SG_PUTP(sl);
    }
#undef SG_WAIT
#undef SG_LOADP
#undef SG_PUTP
#undef SG_LOADV
#undef SG_LOADU
    __syncthreads();
}
}

#define XB_TMO      128
#define XB_XCNT(j)  (256  + 64 * (j))
#define XB_XSUB(j)  (1280 + 64 * (j))
#define XB_XGEN(j)  (2304 + 64 * (j))
#define XB_TOP      3328
#define XB_TOPGEN   3392
#define XCD_BAR_WORDS 3456
#define XB_SPIN_CAP (1u << 22)
__device__ __forceinline__ unsigned xb_ld(unsigned* p)              { return __hip_atomic_load(p, __ATOMIC_RELAXED, __HIP_MEMORY_SCOPE_AGENT); }
__device__ __forceinline__ unsigned xb_add(unsigned* p, unsigned v) { return __hip_atomic_fetch_add(p, v, __ATOMIC_RELAXED, __HIP_MEMORY_SCOPE_AGENT); }
__device__ __forceinline__ unsigned xb_xcc_id() { return (unsigned)__builtin_amdgcn_s_getreg((3 << 11) | 20) & 0xFu; }
#define XB_SPIN(cond, bar) do { unsigned _sp = 0; while (cond) { __builtin_amdgcn_s_sleep(1); \
    if ((++_sp & 255u) == 0u) { if (xb_ld(&(bar)[XB_TMO])) break; if (_sp > XB_SPIN_CAP) { atomicAdd(&(bar)[XB_TMO], 1u); break; } } } } while (0)
struct XcdBarrier { unsigned* bar; unsigned x; volatile LAS unsigned* st; int wv; };
__device__ __forceinline__ XcdBarrier xcd_barrier_post(unsigned* bar, volatile LAS unsigned* st, int wv) {
    XcdBarrier b; b.bar = bar; b.x = xb_xcc_id(); b.st = st; b.wv = wv;
    if (wv == 0 && lane_id() == 0) (void)xb_add(&bar[XB_XCNT(b.x)], 1u);
    return b;
}
__device__ __forceinline__ void xcd_barrier_complete(unsigned* bar, unsigned x, unsigned& nloc, unsigned& nx) {
    const unsigned G = gridDim.x * gridDim.y * gridDim.z;
    unsigned sum, cnt, mine, sp = 0u;
    for (;;) {
        sum = 0u; cnt = 0u; mine = 0u;
#pragma unroll
        for (unsigned j = 0; j < 16; ++j) { const unsigned c = xb_ld(&bar[XB_XCNT(j)]); sum += c; cnt += (c > 0u) ? 1u : 0u; mine = (j == x) ? c : mine; }
        if (sum == G) break;
        __builtin_amdgcn_s_sleep(1);
        if ((++sp & 255u) == 0u) { if (xb_ld(&bar[XB_TMO])) break; if (sp > XB_SPIN_CAP) { atomicAdd(&bar[XB_TMO], 1u); break; } }
    }
    nloc = mine > 0u ? mine : 1u; nx = cnt > 0u ? cnt : 1u;
}
__device__ __forceinline__ void xcd_barrier(const XcdBarrier& b) {
    asm volatile("s_waitcnt vmcnt(0)" ::: "memory");
    __syncthreads();
    int l0_ = lane_id(); asm volatile("" : "+v"(l0_));
    if (b.wv == 0 && l0_ == 0) {
        unsigned* bar = b.bar; unsigned bx_ = __builtin_amdgcn_readfirstlane(b.x);
        asm volatile("" : "+s"(bar), "+s"(bx_));
        __builtin_amdgcn_s_waitcnt(0);
        unsigned nloc = b.st[0], nx = b.st[1];
        if (nloc == 0u) { xcd_barrier_complete(bar, bx_, nloc, nx); b.st[0] = nloc; b.st[1] = nx; }
        const unsigned old = xb_add(&bar[XB_XSUB(bx_)], 1u);
        const unsigned gen = old / nloc;
        if (old + 1u == (gen + 1u) * nloc) {
            __builtin_amdgcn_fence(__ATOMIC_RELEASE, "agent");
            asm volatile("s_waitcnt vmcnt(0)" ::: "memory");
            const unsigned og = xb_add(&bar[XB_TOP], 1u);
            const unsigned tg = og / nx;
            if (og + 1u == (tg + 1u) * nx) xb_add(&bar[XB_TOPGEN], 1u);
            else XB_SPIN(xb_ld(&bar[XB_TOPGEN]) == tg, bar);
            __builtin_amdgcn_fence(__ATOMIC_ACQUIRE, "agent");
            xb_add(&bar[XB_XGEN(bx_)], 1u);
            asm volatile("s_waitcnt vmcnt(0)" ::: "memory");
        } else {
            XB_SPIN(xb_ld(&bar[XB_XGEN(bx_)]) == gen, bar);
            __builtin_amdgcn_fence(__ATOMIC_ACQUIRE, "agent");
            asm volatile("s_waitcnt vmcnt(0)" ::: "memory");
        }
    }
    __syncthreads();
}

struct TItem { const float* src; int N; bf16* dst; int ldk; };
__device__ __forceinline__ void titem_load(const TItem& t, f32x4 (&v)[8], int lane) {
    const float* src = t.src + (size_t)(lane >> 3) * t.N + (lane & 7) * 4;
#pragma unroll
    for (int i = 0; i < 8; ++i) v[i] = __builtin_nontemporal_load((const f32x4*)(src + (size_t)(8 * i) * t.N));
}
__device__ __forceinline__ void titem_store(const TItem& t, const f32x4 (&v)[8], LAS float* scr, int lane) {
#pragma unroll
    for (int i = 0; i < 8; ++i) { LAS float* d = scr + (8 * i + (lane >> 3)) * 33 + (lane & 7) * 4; d[0] = v[i].x; d[1] = v[i].y; d[2] = v[i].z; d[3] = v[i].w; }
    LDS_WAIT(); asm volatile("" ::: "memory");
    const int c = lane & 7;
#pragma unroll
    for (int j = 0; j < 4; ++j) { const int n = (lane >> 3) + 8 * j; const LAS float* s = scr + (8 * c) * 33 + n;
        u32x4 o; o.x = cvt_pk_bf16(s[0 * 33], s[1 * 33]); o.y = cvt_pk_bf16(s[2 * 33], s[3 * 33]); o.z = cvt_pk_bf16(s[4 * 33], s[5 * 33]); o.w = cvt_pk_bf16(s[6 * 33], s[7 * 33]);
        *(u32x4*)(t.dst + (size_t)n * t.ldk + 8 * c) = o; }
    LDS_WAIT(); asm volatile("" ::: "memory");
}
__device__ __forceinline__ TItem plain_item(const float* W, int K, int N, bf16* WT, int it) {
    const int nblk = N / 32, kb = it / nblk, nb = it % nblk;
    return TItem{W + (size_t)(64 * kb) * N + 32 * nb, N, WT + (size_t)(32 * nb) * K + 64 * kb, K};
}
__device__ __forceinline__ void transpose_matrix(const float* W, int K, int N, bf16* WT, LAS float* scr, int gw, int ngw, int lane) {
    const int nitems = (K / 64) * (N / 32);
    int it = gw; if (it >= nitems) return;
    f32x4 v[8], vn[8]; TItem t = plain_item(W, K, N, WT, it); titem_load(t, vn, lane);
    for (; it < nitems; it += ngw) {
#pragma unroll
        for (int i = 0; i < 8; ++i) v[i] = vn[i];
        const TItem tc = t;
        if (it + ngw < nitems) { t = plain_item(W, K, N, WT, it + ngw); titem_load(t, vn, lane); }
        titem_store(tc, v, scr, lane);
    }
}
__device__ __forceinline__ TItem moe_item(const float* wg, const float* wu, const float* wd, bf16* B1, bf16* B2, int it) {
    constexpr int IPE = 3 * 256;
    const int e = it / IPE, r = it % IPE, m = r >> 8, q = r & 255;
    if (m < 2) { const int kb = q >> 4, nb = q & 15; const int n0 = 32 * nb;
        const float* W = (m == 0 ? wg : wu) + (size_t)e * D * MOEH;
        const int row_off = (n0 >> 7) * 256 + m * 128 + (n0 & 127);
        return TItem{W + (size_t)(64 * kb) * MOEH + n0, MOEH, B1 + (size_t)e * D * D + (size_t)row_off * D + 64 * kb, D}; }
    const int kb = q >> 5, nb = q & 31;
    return TItem{wd + (size_t)e * MOEH * D + (size_t)(64 * kb) * D + 32 * nb, D, B2 + (size_t)e * D * MOEH + (size_t)(32 * nb) * MOEH + 64 * kb, MOEH};
}
__device__ __forceinline__ void convert_moe(const float* wg, const float* wu, const float* wd, bf16* B1, bf16* B2, LAS float* scr, int gw, int ngw, int lane) {
    constexpr int NIT = NEXP * 3 * 256;
    int it = gw; if (it >= NIT) return;
    f32x4 v[8], vn[8]; TItem t = moe_item(wg, wu, wd, B1, B2, it); titem_load(t, vn, lane);
    for (; it < NIT; it += ngw) {
#pragma unroll
        for (int i = 0; i < 8; ++i) v[i] = vn[i];
        const TItem tc = t;
        if (it + ngw < NIT) { t = moe_item(wg, wu, wd, B1, B2, it + ngw); titem_load(t, vn, lane); }
        titem_store(tc, v, scr, lane);
    }
}
#define TLOAD(BUF, T) do { const float* src_ = (T).src + (size_t)(lane >> 3) * (T).N + (lane & 7) * 4; \
    _Pragma("unroll") for (int i = 0; i < 8; ++i) { const float* p_ = src_ + (size_t)(8 * i) * (T).N; asm volatile("global_load_dwordx4 %0, %1, off nt" : "=&v"(BUF[i]) : "v"(p_) : "memory"); } } while (0)
#define TWAIT(BUF, N) asm volatile("s_waitcnt vmcnt(" #N ")" : "+v"(BUF[0]), "+v"(BUF[1]), "+v"(BUF[2]), "+v"(BUF[3]), "+v"(BUF[4]), "+v"(BUF[5]), "+v"(BUF[6]), "+v"(BUF[7]) :: "memory")
__device__ __forceinline__ TItem moe_item2(const float* wg, const float* wu, const float* wd, bf16* B1a, bf16* B2a, bf16* B1b, bf16* B2b, int it) {
    constexpr int NIT = NEXP * 3 * 256;
    const int L = it >= NIT ? 1 : 0; it -= L * NIT;
    return moe_item(wg + (size_t)L * NEXP * D * MOEH, wu + (size_t)L * NEXP * D * MOEH, wd + (size_t)L * NEXP * MOEH * D, L ? B1b : B1a, L ? B2b : B2a, it);
}
__device__ __forceinline__ void convert_slice(const float* wg, const float* wu, const float* wd, bf16* B1a, bf16* B2a, bf16* B1b, bf16* B2b, int s, LAS float* scr, int gw, int lane) {
    constexpr int NW = GRID * NWAVES;
    static_assert(2 * NEXP * 3 * 256 == 48 * NW, "convert_slice: 48 items per wave, 6 per slice");
#define CS_ITEM(K) moe_item2(wg, wu, wd, B1a, B2a, B1b, B2b, it + (K) * NW)
    const int it = gw + 6 * s * NW;
    f32x4 b0[8], b1[8], b2[8]; TItem t0 = CS_ITEM(0), t1 = CS_ITEM(1), t2;
    TLOAD(b0, t0); TLOAD(b1, t1);
    t2 = CS_ITEM(2); TLOAD(b2, t2); TWAIT(b0, 16); titem_store(t0, b0, scr, lane); t0 = CS_ITEM(3); TLOAD(b0, t0); TWAIT(b1, 20); titem_store(t1, b1, scr, lane);
    t1 = CS_ITEM(4); TLOAD(b1, t1); TWAIT(b2, 24); titem_store(t2, b2, scr, lane);
    t2 = CS_ITEM(5); TLOAD(b2, t2); TWAIT(b0, 24); titem_store(t0, b0, scr, lane); TWAIT(b1, 16); titem_store(t1, b1, scr, lane); TWAIT(b2, 8); titem_store(t2, b2, scr, lane);
#undef CS_ITEM
}
#undef TLOAD
#undef TWAIT
__device__ __forceinline__ int t5_bucket(int n) {
    if (n < 16) return n;
    int large = 16 + (int)(logf((float)n / 16.0f) / logf(8.0f) * 16.0f);
    return large < 31 ? large : 31;
}

__device__ __forceinline__ void ln_params(const float* g, const float* b, float (&gr)[16], float (&br)[16], int lane) {
#pragma unroll
    for (int j = 0; j < 2; ++j) { const int c = 8 * lane + 512 * j;
        const f32x4 g0 = *(const f32x4*)(g + c), g1 = *(const f32x4*)(g + c + 4), b0 = *(const f32x4*)(b + c), b1 = *(const f32x4*)(b + c + 4);
#pragma unroll
        for (int k = 0; k < 4; ++k) { gr[8 * j + k] = g0[k]; gr[8 * j + 4 + k] = g1[k]; br[8 * j + k] = b0[k]; br[8 * j + 4 + k] = b1[k]; } }
}
template <bool F32OUT>
__device__ __forceinline__ void ln_store16(float (&v)[16], const float (&gr)[16], const float (&br)[16], float* orow, bf16* brow, int lane) {
    float s = 0.f;
#pragma unroll
    for (int i = 0; i < 16; ++i) s += v[i];
    const float mean = wave_sum(s) * (1.f / D); float s2 = 0.f;
#pragma unroll
    for (int i = 0; i < 16; ++i) { v[i] -= mean; s2 += v[i] * v[i]; }
    const float rstd = 1.f / sqrtf(wave_sum(s2) * (1.f / D) + LN_EPS);
#pragma unroll
    for (int j = 0; j < 2; ++j) { const int c = 8 * lane + 512 * j;
        f32x4 y0, y1;
#pragma unroll
        for (int k = 0; k < 4; ++k) { y0[k] = v[8 * j + k] * rstd * gr[8 * j + k] + br[8 * j + k]; y1[k] = v[8 * j + 4 + k] * rstd * gr[8 * j + 4 + k] + br[8 * j + 4 + k]; }
        if constexpr (F32OUT) { *(f32x4*)(orow + c) = y0; *(f32x4*)(orow + c + 4) = y1; }
        else { u32x4 w; w.x = cvt_pk_bf16(y0[0], y0[1]); w.y = cvt_pk_bf16(y0[2], y0[3]); w.z = cvt_pk_bf16(y1[0], y1[1]); w.w = cvt_pk_bf16(y1[2], y1[3]); *(u32x4*)(brow + c) = w; } }
}
__device__ __forceinline__ void unpack8(const u32x4 w, float* v) { v[0] = bf_lo(w.x); v[1] = bf_hi(w.x); v[2] = bf_lo(w.y); v[3] = bf_hi(w.y); v[4] = bf_lo(w.z); v[5] = bf_hi(w.z); v[6] = bf_lo(w.w); v[7] = bf_hi(w.w); }

#ifndef ACT_ON
#define ACT_ON 1
#endif
#ifndef STAG_TICKS
#define STAG_TICKS 1500
#endif
#ifndef PROBE_CLK
#define PROBE_CLK 0
#endif
#ifndef PROBE_P0
#define PROBE_P0 1
#endif
#ifndef PROBE_ATTN
#define PROBE_ATTN 1
#endif
#ifndef PROBE_NOSTORE
#define PROBE_NOSTORE 0
#endif
#ifndef PROBE_QKV
#define PROBE_QKV 1
#endif
#ifndef PROBE_WO
#define PROBE_WO 1
#endif
#ifndef PROBE_GIN
#define PROBE_GIN 1
#endif
#ifndef PROBE_MOE
#define PROBE_MOE 1
#endif
#ifndef PHASES
#define PHASES 0xFFFF
#endif
#define PH(k) ((PHASES >> (k)) & 1)
struct Params { const float* in[22]; float* out; unsigned char* ws; };
#define CLK_BEGIN() unsigned long long c0_ = __builtin_amdgcn_s_memtime(), r0_ = __builtin_amdgcn_s_memrealtime()
#define CLK_END() do { const unsigned long long dc_ = __builtin_amdgcn_s_memtime() - c0_, dr_ = __builtin_amdgcn_s_memrealtime() - r0_; \
    if (blockIdx.x == 0) { const unsigned long long w_ = 10000ull * dc_ / (dr_ ? dr_ : 1ull); const unsigned long long t0_ = __builtin_amdgcn_s_memrealtime(); \
        while (__builtin_amdgcn_s_memrealtime() - t0_ < w_) __builtin_amdgcn_s_sleep(8); } } while (0)
__device__ __forceinline__ void stagger(int bx, unsigned ticks) {
    if ((bx >> 3) & 1) { const unsigned long long t0 = __builtin_amdgcn_s_memrealtime(); while (__builtin_amdgcn_s_memrealtime() - t0 < ticks) __builtin_amdgcn_s_sleep(8); }
}
enum { I_X = 0, I_RELB, I_AWIN, I_AWOUT, I_ALAM, I_ASUBG, I_SGWIN, I_SGBIN, I_SGLNG, I_SGLNB, I_SGWS, I_SGBS, I_SGWOUT,
       I_MWG, I_MBG, I_MWR, I_MBR, I_MWGATE, I_MWUP, I_MWDOWN, I_LNG, I_LNB };
typedef const __attribute__((address_space(4))) Params* kparams_t;
#define LAUNDER_S(x) ({ int _v = (x); asm volatile("" : "+s"(_v)); _v; })
#define KP() ({ kparams_t _k = (kparams_t)__builtin_amdgcn_kernarg_segment_ptr(); asm volatile("" : "+s"(_k)); _k; })

__global__ void __launch_bounds__(NTHREADS, 2) mega_fwd(Params p_unused) {
    extern __shared__ __attribute__((aligned(16))) unsigned char lds_raw[];
    lds_u8* lds = (lds_u8*)lds_raw;
    const int G0 = gridDim.x, bx0 = blockIdx.x;
    const int wv = __builtin_amdgcn_readfirstlane(threadIdx.x >> 6);
#define PHASE_IDS() const int tid = tid_opaque(wv), lane = tid & 63, wave = wv; (void)lane; (void)wave; \
    const int bxp = LAUNDER_S(bx0), Gp = LAUNDER_S(G0), vcu = (Gp % 8 == 0) ? (bxp % 8) * (Gp / 8) + bxp / 8 : bxp; (void)vcu; \
    const int gw = vcu * NWAVES + wave, ngw = Gp * NWAVES, gtid = bxp * NTHREADS + tid, ngt = Gp * NTHREADS; (void)gw; (void)ngw; (void)gtid; (void)ngt
    for (int u = threadIdx.x; u < (LDS_BYTES - LDSCTL_OFF) / 4; u += NTHREADS) ((LAS unsigned*)(lds + LDSCTL_OFF))[u] = 0u;
    __syncthreads();
    XcdBarrier bar;
    { kparams_t kp = KP(); const int bx = LAUNDER_S(bx0), G = LAUNDER_S(G0); (void)bx; (void)G; bar = xcd_barrier_post((unsigned*)(kp->ws + WS_CTL) + 4096, (volatile LAS unsigned*)(lds + L_MISC), wv); }
#define GRID_BAR() xcd_barrier(bar)

#pragma unroll 1
    for (int rep_ = 0; rep_ < PROBE_P0; ++rep_)
    if (PH(0)) {
        PHASE_IDS(); kparams_t kp = KP(); const int bx = LAUNDER_S(bx0), G = LAUNDER_S(G0); (void)bx; (void)G; unsigned char* ws = kp->ws;
        LAS float* scr = (LAS float*)(lds + wave * 16384);
        transpose_matrix(kp->in[I_AWOUT], D, D, (bf16*)(ws + WS_WO), scr, gw, ngw, lane);
        transpose_matrix(kp->in[I_SGWIN], D, 2 * SGH, (bf16*)(ws + WS_W1), scr, gw, ngw, lane);
        transpose_matrix(kp->in[I_SGWOUT], SGH, D, (bf16*)(ws + WS_W2), scr, gw, ngw, lane);
        { const float* wgp = kp->in[I_MWG]; const float* wrp = kp->in[I_MWR]; bf16* wr_t = (bf16*)(ws + WS_WR);
          for (int i = gtid; i < 2 * 256 * D; i += ngt) { const int l = i / (256 * D), n = (i / D) % 256, k = i % D;
              float v = 0.f; if (n < 8) v = wgp[(size_t)l * D * 8 + k * 8 + n]; else if (n < 72) v = wrp[(size_t)l * D * 64 + k * 64 + (n - 8)];
              wr_t[i] = (bf16)(cvt_pk_bf16(v, 0.f) & 0xffffu); } }
        { const float* w_s = kp->in[I_SGWS]; bf16* wtril = (bf16*)(ws + WS_WTRIL);
          for (int i = gtid; i < SGG * SGC * SGC; i += ngt) { const int t = (i / SGC) % SGC, s_ = i % SGC; const float v = (s_ <= t) ? w_s[i] : 0.f; wtril[i] = (bf16)(cvt_pk_bf16(v, 0.f) & 0xffffu); } }
        { const float* rel_bias = kp->in[I_RELB]; float* dtab = (float*)(ws + WS_DTAB);
          for (int i = gtid; i < NHEAD * 128; i += ngt) { const int h = i / 128, d = i % 128; dtab[i] = (rel_bias[t5_bucket(d) * NHEAD + h] - rel_bias[31 * NHEAD + h]) * LOG2E; } }
        transpose_matrix(kp->in[I_AWIN], D, NQKV, (bf16*)(ws + WS_WQKV), scr, gw, ngw, lane);
        { const float* x = kp->in[I_X]; bf16* hb = (bf16*)(ws + WS_HB);
#pragma unroll 4
          for (size_t i = gtid; i < (size_t)NTOK * D / 8; i += ngt) { const f32x4 a = __builtin_nontemporal_load((const f32x4*)(x + i * 8)), b = __builtin_nontemporal_load((const f32x4*)(x + i * 8 + 4));
              u32x4 w; w.x = cvt_pk_bf16(a.x, a.y); w.y = cvt_pk_bf16(a.z, a.w); w.z = cvt_pk_bf16(b.x, b.y); w.w = cvt_pk_bf16(b.z, b.w); *(u32x4*)(hb + i * 8) = w; } }
    }
    GRID_BAR();

#pragma unroll 1
    for (int layer = 0; layer < 2; ++layer) {
        if (layer == 0) {
            _Pragma("unroll 1") for (int rep_ = 0; rep_ < PROBE_QKV; ++rep_)
            if (PH(1)) { kparams_t kp = KP(); const int bx = LAUNDER_S(bx0), G = LAUNDER_S(G0); (void)bx; (void)G; unsigned char* ws = kp->ws;
              pg8::Gemm g{(const bf16*)(ws + WS_HB), (const bf16*)(ws + WS_WQKV), D, 0}; pg8::StaticOrder S{NTOK / 256, NQKV / 256, G, bx};
              pg8::EpiBf16<0> E{(bf16*)(ws + WS_QKV), NQKV, nullptr, D, (size_t)D, 0.125f * LOG2E, PROBE_NOSTORE ? rep_ : 0, nullptr};
              pg8::gemm_phase<pg8::EpiBf16<0>, pg8::StaticOrder, true, false>(lds, g, S, E, wv); }
#ifdef PROBE_NULLQKV
            { kparams_t kp = KP(); const int bx = LAUNDER_S(bx0), G = LAUNDER_S(G0); (void)bx; (void)G; unsigned char* ws = kp->ws;
              pg8::Gemm g{(const bf16*)(ws + WS_HB), (const bf16*)(ws + WS_WQKV), D, 0}; pg8::StaticOrder S{NTOK / 256, NQKV / 256, G, bx};
              pg8::EpiNull E{(f32x4*)(ws + WS_OB)};
              pg8::gemm_phase<pg8::EpiNull, pg8::StaticOrder, true, false>(lds, g, S, E, wv); }
#endif
            GRID_BAR();
#if PROBE_CLK == 1
            CLK_BEGIN();
#endif
            if (PH(2)) { PHASE_IDS(); kparams_t kp = KP(); const int bx = LAUNDER_S(bx0), G = LAUNDER_S(G0); (void)bx; (void)G; unsigned char* ws = kp->ws;
              float lam;
              { const float* al = kp->in[I_ALAM]; const float a = al[lane] * al[64 + lane], b = al[128 + lane] * al[192 + lane];
                lam = __expf(wave_sum(a)) - __expf(wave_sum(b)) + 0.2f; }
              const int grp = vcu >> 3, jj = vcu & 7;
#pragma unroll 1
              for (int i = 0; i < 8 * PROBE_ATTN; ++i) { const int bh = grp * 4 + ((i & 7) >> 1); const int qt = (i & 1) ? jj : 15 - jj;
                  da::attn_unit(bh >> 3, bh & 7, qt, (const bf16*)(ws + WS_QKV), (bf16*)(ws + WS_OB), (const float*)(ws + WS_DTAB), kp->in[I_ASUBG], lam, lds, wv);
                  __syncthreads();
                  convert_slice(kp->in[I_MWGATE], kp->in[I_MWUP], kp->in[I_MWDOWN], (bf16*)(ws + WS_MOE1), (bf16*)(ws + WS_MOE2), (bf16*)kp->out, (bf16*)kp->out + (size_t)NEXP * D * D,
                                i & 7, (LAS float*)(lds + wave * 16384), gw, lane);
                  __syncthreads(); } }
#if PROBE_CLK == 1
            CLK_END();
#endif
            GRID_BAR();
            _Pragma("unroll 1") for (int rep_ = 0; rep_ < PROBE_WO; ++rep_)
            if (PH(3)) { kparams_t kp = KP(); const int bx = LAUNDER_S(bx0), G = LAUNDER_S(G0); (void)bx; (void)G; unsigned char* ws = kp->ws;
              pg8::Gemm g{(const bf16*)(ws + WS_OB), (const bf16*)(ws + WS_WO), D, 0}; pg8::RowOrder S{bx, D / 256};
              pg8::EpiResBf16 E{(const bf16*)(ws + WS_HB), (bf16*)(ws + WS_HB), D, DN_ALPHA};
              pg8::gemm_phase<pg8::EpiResBf16, pg8::RowOrder, true, false>(lds, g, S, E, wv); }
            VM_WAIT(); __syncthreads(); __builtin_amdgcn_fence(__ATOMIC_ACQUIRE, "agent"); VM_WAIT(); __syncthreads();
        } else {
#if PROBE_CLK == 2
            CLK_BEGIN();
#endif
            _Pragma("unroll 1") for (int rep_ = 0; rep_ < PROBE_GIN; ++rep_)
            if (PH(4)) { kparams_t kp = KP(); const int bx = LAUNDER_S(bx0), G = LAUNDER_S(G0); (void)bx; (void)G; unsigned char* ws = kp->ws;
              pg8::Gemm g{(const bf16*)(ws + WS_HB), (const bf16*)(ws + WS_W1), D, 0}; pg8::StaticOrder S{NTOK / 256, 2 * SGH / 256, G, bx};
              pg8::EpiBf16<1> E{(bf16*)(ws + WS_U), SGH, kp->in[I_SGBIN], SGH, (size_t)(WS_V - WS_U) / 2, 1.f, PROBE_NOSTORE ? rep_ : 0, (f32x2*)(ws + WS_VSTAT)};
              pg8::gemm_phase<pg8::EpiBf16<1>, pg8::StaticOrder, true, false>(lds, g, S, E, wv); }
#if PROBE_CLK == 2
            CLK_END();
#endif
            GRID_BAR();
            if (PH(5)) { kparams_t kp = KP(); const int bx = LAUNDER_S(bx0), G = LAUNDER_S(G0); (void)bx; (void)G; unsigned char* ws = kp->ws;
#pragma unroll 1
              for (int ch = bx; ch < NTOK / SGC; ch += G)
                  sg::chunk_unit(ch, (bf16*)(ws + WS_U), (const bf16*)(ws + WS_V), (const f32x2*)(ws + WS_VSTAT), kp->in[I_SGLNG], kp->in[I_SGLNB], (const bf16*)(ws + WS_WTRIL), kp->in[I_SGBS], lds, wv); }
            GRID_BAR();
            if (PH(6)) { kparams_t kp = KP(); const int bx = LAUNDER_S(bx0), G = LAUNDER_S(G0); (void)bx; (void)G; unsigned char* ws = kp->ws;
              pg8::Gemm g{(const bf16*)(ws + WS_U), (const bf16*)(ws + WS_W2), SGH, 0}; pg8::StaticOrder S{NTOK / 256, D / 256, G, bx};
              pg8::EpiResBf16 E{(const bf16*)(ws + WS_HB), (bf16*)(ws + WS_HB), D, DN_ALPHA};
              pg8::gemm_phase<pg8::EpiResBf16, pg8::StaticOrder, true, false>(lds, g, S, E, wv); }
            GRID_BAR();
        }
        if (PH(7)) {
            PHASE_IDS();
            { kparams_t kp = KP(); const int bx = LAUNDER_S(bx0), G = LAUNDER_S(G0); (void)bx; (void)G; unsigned char* ws = kp->ws; bf16* hb = (bf16*)(ws + WS_HB);
              const float* g1 = kp->in[I_LNG] + (size_t)(layer * 2 + 0) * D; const float* b1 = kp->in[I_LNB] + (size_t)(layer * 2 + 0) * D;
              float gr[16], br[16]; ln_params(g1, b1, gr, br, lane); __builtin_amdgcn_s_waitcnt(0x0F70);
              u32x4 q[4][2]; const size_t row0 = (size_t)bx * 256 + wave * 32;
#define LN1_LOAD(K, ROW) do { const bf16* r_ = hb + (ROW) * D + 8 * lane; GLOAD16(q[K][0], r_, 0); GLOAD16(q[K][1], r_, 1024); } while (0)
#define LN1_WAIT(K, N) asm volatile("s_waitcnt vmcnt(" #N ")" : "+v"(q[K][0]), "+v"(q[K][1]) :: "memory")
#define LN1_PROC(K, ROW) do { float va[16]; unpack8(q[K][0], va); unpack8(q[K][1], va + 8); ln_store16<false>(va, gr, br, nullptr, hb + (ROW) * D, lane); } while (0)
#define LN1_ITER(ROW, N0, N1, N2, N3) do { const size_t row = (ROW); \
    LN1_LOAD(3, row + 3); LN1_WAIT(0, N0); LN1_PROC(0, row); LN1_LOAD(0, row + 4); LN1_WAIT(1, N1); LN1_PROC(1, row + 1); LN1_LOAD(1, row + 5); LN1_WAIT(2, N2); LN1_PROC(2, row + 2); \
    LN1_LOAD(2, row + 6); LN1_WAIT(3, N3); LN1_PROC(3, row + 3); } while (0)
              LN1_LOAD(0, row0); LN1_LOAD(1, row0 + 1); LN1_LOAD(2, row0 + 2);
              LN1_ITER(row0, 6, 8, 10, 12);
#pragma unroll 1
              for (int i = 4; i < 28; i += 4) LN1_ITER(row0 + i, 12, 12, 12, 12);
              { const size_t row = row0 + 28; LN1_LOAD(3, row + 3); LN1_WAIT(0, 12); LN1_PROC(0, row); LN1_WAIT(1, 10); LN1_PROC(1, row + 1); LN1_WAIT(2, 8); LN1_PROC(2, row + 2); LN1_WAIT(3, 6); LN1_PROC(3, row + 3); }
#undef LN1_ITER
#undef LN1_LOAD
#undef LN1_WAIT
#undef LN1_PROC
              VM_WAIT(); __builtin_amdgcn_fence(__ATOMIC_ACQUIRE, "agent"); VM_WAIT(); __syncthreads(); }
            { kparams_t kp = KP(); const int bx = LAUNDER_S(bx0), G = LAUNDER_S(G0); (void)bx; (void)G; unsigned char* ws = kp->ws;
              pg8::Gemm g{(const bf16*)(ws + WS_HB), (const bf16*)(ws + WS_WR) + (size_t)layer * 256 * D, D, 0}; pg8::SingleOrder S{bx};
              pg8::EpiRouter E{kp->in[I_MBG] + layer * 8, kp->in[I_MBR] + layer * 64};
              pg8::gemm_phase<pg8::EpiRouter, pg8::SingleOrder, false, false>(lds, g, S, E, wv); }
            LAS int* wcnt = (LAS int*)(lds + L_WCNT);
            if (tid < 64) wcnt[tid] = 0;
            __syncthreads();
            if (tid < 256) { kparams_t kp = KP(); const int bx = LAUNDER_S(bx0), G = LAUNDER_S(G0); (void)bx; (void)G; unsigned char* ws = kp->ws; int* aexp = (int*)(ws + WS_AEXP); float* agate = (float*)(ws + WS_AGATE);
                const LAS float* lg = (const LAS float*)lds + tid * 73;
                float gmax = lg[0]; int gi = 0;
#pragma unroll
                for (int j = 1; j < 8; ++j) { const float v = lg[j]; if (v > gmax) { gmax = v; gi = j; } }
                float gs = 0.f;
#pragma unroll
                for (int j = 0; j < 8; ++j) gs += __expf(lg[j] - gmax);
                const float ggate = 1.0f / gs;
                const LAS float* el = lg + 8 + gi * 8;
                float v1 = el[0]; int i1 = 0;
#pragma unroll
                for (int j = 1; j < 8; ++j) { const float v = el[j]; if (v > v1) { v1 = v; i1 = j; } }
                float v2 = -INFINITY; int i2 = 0;
#pragma unroll
                for (int j = 0; j < 8; ++j) { const float v = el[j]; if (j != i1 && v > v2) { v2 = v; i2 = j; } }
                const float e2 = __expf(v2 - v1), p1 = 1.0f / (1.0f + e2), p2 = e2 * p1;
                const int tok = bx * 256 + tid; const int e1x = gi * 8 + i1, e2x = gi * 8 + i2;
                aexp[2 * tok] = e1x; aexp[2 * tok + 1] = e2x; agate[2 * tok] = ggate * p1; agate[2 * tok + 1] = ggate * p2;
                atomicAdd((int*)&wcnt[e1x], 1); atomicAdd((int*)&wcnt[e2x], 1); }
            __syncthreads();
            if (tid < 64) { kparams_t kp = KP(); const int bx = LAUNDER_S(bx0), G = LAUNDER_S(G0); (void)bx; (void)G; int* hist = (int*)(kp->ws + WS_HIST); hist[bx * 64 + tid] = wcnt[tid]; }
        }
        GRID_BAR();
        LAS int* pstL = (LAS int*)(lds + L_PST);
        if (PH(8)) {
            PHASE_IDS(); kparams_t kp = KP(); const int bx = LAUNDER_S(bx0), G = LAUNDER_S(G0); (void)bx; (void)G; unsigned char* ws = kp->ws; const int* hist = (const int*)(ws + WS_HIST); const int* aexp = (const int*)(ws + WS_AEXP); unsigned* srt = (unsigned*)(ws + WS_SRT);
            LAS int* cntL = (LAS int*)(lds + L_CNT);
            LAS int* offsL = (LAS int*)(lds + L_OFFS); LAS int* wcnt = (LAS int*)(lds + L_WCNT); LAS int* part = (LAS int*)(lds + L_PART);
            { const int e = tid & 63, pt = tid >> 6; int sa = 0, sb = 0;
              for (int w = pt * 32; w < pt * 32 + 32; ++w) { const int hv = hist[w * 64 + e]; sa += hv; if (w < bx) sb += hv; }
              part[pt * 64 + e] = sa; part[512 + pt * 64 + e] = sb; }
            __syncthreads();
            if (tid < 64) { int sa = 0, sb = 0;
#pragma unroll
                for (int pt = 0; pt < 8; ++pt) { sa += part[pt * 64 + tid]; sb += part[512 + pt * 64 + tid]; }
                cntL[tid] = sa; offsL[tid] = sb; wcnt[tid] = 0; }
            __syncthreads();
            if (tid == 0) { int acc = 0; for (int e = 0; e < 64; ++e) { pstL[e] = acc; acc += (cntL[e] + 255) & ~255; } pstL[64] = acc; pstL[65] = acc; pstL[66] = acc; pstL[67] = acc; }
            __syncthreads();
            if (tid < 256) { const int tok = bx * 256 + tid;
#pragma unroll
                for (int k = 0; k < 2; ++k) { const int a = 2 * tok + k; const int e = aexp[a]; const int rank = atomicAdd((int*)&wcnt[e], 1);
                    srt[pstL[e] + offsL[e] + rank] = (unsigned)a; } }
            if (bx < 64) { const int e = bx; const int c = cntL[e], cp = (c + 255) & ~255; for (int i = c + tid; i < cp; i += NTHREADS) srt[pstL[e] + i] = SRT_MARK; }
        }
        GRID_BAR();
        _Pragma("unroll 1") for (int rep_ = 0; rep_ < PROBE_MOE; ++rep_)
            if (PH(9)) { kparams_t kp = KP(); const int bx = LAUNDER_S(bx0), G = LAUNDER_S(G0); (void)bx; (void)G; unsigned char* ws = kp->ws; const int ntile = pstL[64] >> 8;
          pg8::Gemm g{(const bf16*)(ws + WS_HB), layer ? (const bf16*)kp->out : (const bf16*)(ws + WS_MOE1), D, (size_t)D * D * 2}; pg8::MoeOrder S{ntile, G, bx, pstL, (const unsigned*)(ws + WS_SRT), true};
          pg8::EpiSwiglu E{(bf16*)(ws + WS_HM)};
          pg8::gemm_phase<pg8::EpiSwiglu, pg8::MoeOrder, true, true>(lds, g, S, E, wv); }
        GRID_BAR();
        _Pragma("unroll 1") for (int rep_ = 0; rep_ < PROBE_MOE; ++rep_)
            if (PH(10)) { kparams_t kp = KP(); const int bx = LAUNDER_S(bx0), G = LAUNDER_S(G0); (void)bx; (void)G; unsigned char* ws = kp->ws; const int ntile = pstL[64] >> 8;
          pg8::Gemm g{(const bf16*)(ws + WS_HM), layer ? (const bf16*)kp->out + (size_t)NEXP * D * D : (const bf16*)(ws + WS_MOE2), MOEH, (size_t)D * MOEH * 2}; pg8::MoeOrder S{ntile, G, bx, pstL, (const unsigned*)(ws + WS_SRT), false};
          pg8::EpiScatter E{(unsigned char*)(ws + WS_YSLOT), (const unsigned*)(ws + WS_SRT), (const float*)(ws + WS_AGATE)};
          pg8::gemm_phase<pg8::EpiScatter, pg8::MoeOrder, true, false>(lds, g, S, E, wv); }
        GRID_BAR();
        if (PH(11)) {
            PHASE_IDS(); kparams_t kp = KP(); const int bx = LAUNDER_S(bx0), G = LAUNDER_S(G0); (void)bx; (void)G; unsigned char* ws = kp->ws; float* out = kp->out; bf16* hb = (bf16*)(ws + WS_HB); const unsigned char* yslot = (const unsigned char*)(ws + WS_YSLOT);
            const float* g2 = kp->in[I_LNG] + (size_t)(layer * 2 + 1) * D; const float* b2 = kp->in[I_LNB] + (size_t)(layer * 2 + 1) * D;
            const size_t row0 = (size_t)bx * 256 + wave * 32;
            float gr[16], br[16]; ln_params(g2, b2, gr, br, lane); __builtin_amdgcn_s_waitcnt(0x0F70);
            u32x4 hq[4][2]; u32x2 aq[4][2], bq[4][2];
#define LN2_LOAD(K, ROW) do { const bf16* hr_ = hb + (ROW) * D + 8 * lane; const unsigned char* y0_ = yslot + (2 * (ROW)) * D + 8 * lane; \
    GLOAD16(hq[K][0], hr_, 0); GLOAD16(hq[K][1], hr_, 1024); GLOAD8(aq[K][0], y0_, 0); GLOAD8(aq[K][1], y0_, 512); GLOAD8(bq[K][0], y0_, 1024); GLOAD8(bq[K][1], y0_, 1536); } while (0)
#define LN2_WAIT_(K, N) asm volatile("s_waitcnt vmcnt(" #N ")" : "+v"(hq[K][0]), "+v"(hq[K][1]), "+v"(aq[K][0]), "+v"(aq[K][1]), "+v"(bq[K][0]), "+v"(bq[K][1]) :: "memory")
#define LN2_WAIT(K, NA, NB) do { if (L0) LN2_WAIT_(K, NA); else LN2_WAIT_(K, NB); } while (0)
#define Y4(Q) v[8 * j + Q] = h8[Q] * DN_ALPHA + (__builtin_amdgcn_cvt_f32_fp8((int)a.x, Q) + __builtin_amdgcn_cvt_f32_fp8((int)b.x, Q)) * YINV; \
              v[8 * j + 4 + Q] = h8[4 + Q] * DN_ALPHA + (__builtin_amdgcn_cvt_f32_fp8((int)a.y, Q) + __builtin_amdgcn_cvt_f32_fp8((int)b.y, Q)) * YINV
#define LN2_PROC(K, ROW) do { float v[16]; \
    _Pragma("unroll") for (int j = 0; j < 2; ++j) { float h8[8]; unpack8(hq[K][j], h8); const u32x2 a = aq[K][j], b = bq[K][j]; Y4(0); Y4(1); Y4(2); Y4(3); } \
    if (L0) ln_store16<false>(v, gr, br, nullptr, hb + (ROW) * D, lane); else ln_store16<true>(v, gr, br, out + (ROW) * D, nullptr, lane); } while (0)
#define LN2_ITER(ROW, A0, B0, A1, B1, A2, B2, A3, B3) do { const size_t row = (ROW); \
    LN2_LOAD(3, row + 3); LN2_WAIT(0, A0, B0); LN2_PROC(0, row); LN2_LOAD(0, row + 4); LN2_WAIT(1, A1, B1); LN2_PROC(1, row + 1); LN2_LOAD(1, row + 5); LN2_WAIT(2, A2, B2); LN2_PROC(2, row + 2); \
    LN2_LOAD(2, row + 6); LN2_WAIT(3, A3, B3); LN2_PROC(3, row + 3); } while (0)
#define LN2_SWEEP() do { LN2_LOAD(0, row0); LN2_LOAD(1, row0 + 1); LN2_LOAD(2, row0 + 2); \
            LN2_ITER(row0, 18, 18, 20, 22, 22, 26, 24, 30); \
            _Pragma("unroll 1") for (int i = 4; i < 28; i += 4) LN2_ITER(row0 + i, 24, 30, 24, 30, 24, 30, 24, 30); \
            { const size_t row = row0 + 28; LN2_LOAD(3, row + 3); LN2_WAIT(0, 24, 30); LN2_PROC(0, row); LN2_WAIT(1, 18, 24); LN2_PROC(1, row + 1); LN2_WAIT(2, 12, 18); LN2_PROC(2, row + 2); \
              LN2_WAIT(3, 6, 12); LN2_PROC(3, row + 3); } } while (0)
            if (layer == 0) { constexpr bool L0 = true; LN2_SWEEP(); } else { constexpr bool L0 = false; LN2_SWEEP(); }
#undef LN2_SWEEP
#undef LN2_ITER
#undef LN2_WAIT
#undef LN2_WAIT_
#undef LN2_LOAD
#undef LN2_PROC
#undef Y4
        }
        if (layer == 0) GRID_BAR();
    }
}

extern "C" void kernel_launch(void* const* d_in, const int* in_sizes, int n_in, void* d_out, int out_size, void* d_ws, size_t ws_size, hipStream_t stream) {
    static int ok = 0;
    if (ok == 0) {
        if (n_in != 22 || in_sizes[0] != NTOK * D || out_size != NTOK * D || ws_size < WS_END) {
            fprintf(stderr, "kernel_launch: shape mismatch: n_in %d in0 %d out %d ws %zu (need %zu)\n", n_in, n_in > 0 ? in_sizes[0] : -1, out_size, ws_size, (size_t)WS_END); ok = -1; return; }
        if (hipFuncSetAttribute((const void*)mega_fwd, hipFuncAttributeMaxDynamicSharedMemorySize, LDS_BYTES) != hipSuccess) { fprintf(stderr, "kernel_launch: hipFuncSetAttribute failed\n"); ok = -1; return; }
        int per_cu = 0;
        if (hipOccupancyMaxActiveBlocksPerMultiprocessor(&per_cu, (const void*)mega_fwd, NTHREADS, LDS_BYTES) != hipSuccess || per_cu < 1)
            fprintf(stderr, "kernel_launch: occupancy query reports %d workgroups per CU\n", per_cu);
        (void)hipGetLastError();
        ok = 1;
    }
    if (ok < 0) return;
    if (hipMemsetAsync((char*)d_ws + WS_CTL, 0, CTL_ZERO_BYTES, stream) != hipSuccess) { fprintf(stderr, "kernel_launch: memset failed\n"); return; }
    Params p{};
    for (int i = 0; i < 22; ++i) p.in[i] = (const float*)d_in[i];
    p.out = (float*)d_out; p.ws = (unsigned char*)d_ws;
    hipLaunchKernelGGL(mega_fwd, dim3(GRID), dim3(NTHREADS), LDS_BYTES, stream, p);
    const hipError_t le = hipPeekAtLastError();
    if (le != hipSuccess) fprintf(stderr, "kernel_launch: launch failed: %s\n", hipGetErrorName(le));
}
```
